# Optimizing an MI355X kernel written in HIP

```python
import math
import jax
import jax.numpy as jnp
from jax import lax
import numpy as np

D_MODEL = 2048
BATCH = 4
SEQ = 4096
DEPTH = 2

CHUNK = 64
Q_BLOCK = 128
A_HEADS = 8
A_KV_HEADS = 2
A_HEAD_DIM = 128
IDX_HEADS = 16
IDX_DIM = 64
TOPK_MAX = 256
REL_BUCKETS = 32
REL_MAX_DIST = 128
R_HEADS = 4
R_HEAD_DIM = 256
ROPE_BASE = 10000.0
A_Q = A_HEADS * A_HEAD_DIM
A_KV = A_KV_HEADS * A_HEAD_DIM
IDX_Q = IDX_HEADS * IDX_DIM
R_W = R_HEADS * R_HEAD_DIM
PROJ_SIZES = (A_Q, A_KV, A_KV, IDX_Q, IDX_DIM, IDX_HEADS, R_W, R_W, R_W, R_W)
IN_WIDTH = sum(PROJ_SIZES)
MIX_OUT = A_Q + R_W
D_FF = 5632
N_EXPERTS = 8
TOP_K = 2
D_FF_EXPERT = 7168
N_DENSE = (DEPTH + 1) // 2
N_MOE = DEPTH // 2
EPS = 1e-6
GN_EPS = 1e-5

kernel_name = 'hybrid_dsa_retention_moe_block'


def rms_norm(x, gain):
    xf = x.astype(jnp.float32)
    y = xf * lax.rsqrt(jnp.mean(xf * xf, axis=-1, keepdims=True) + EPS)
    return (y * gain.astype(jnp.float32)).astype(x.dtype)


def t5_bucket(rel):
    half = REL_BUCKETS // 2
    max_exact = half // 2
    ret = jnp.where(rel > 0, half, 0)
    n = jnp.abs(rel)
    nf = jnp.maximum(n, 1).astype(jnp.float32)
    large = max_exact + (jnp.log(nf / max_exact) / math.log(REL_MAX_DIST / max_exact)
                         * (half - max_exact)).astype(jnp.int32)
    large = jnp.minimum(large, half - 1)
    return ret + jnp.where(n < max_exact, n, large)


def rotary(x, pos):
    half = x.shape[-1] // 2
    inv = ROPE_BASE ** (-jnp.arange(half, dtype=jnp.float32) / half)
    ang = pos[:, None] * inv[None, :]
    cos = jnp.cos(ang)[:, None, :]
    sin = jnp.sin(ang)[:, None, :]
    x1, x2 = x[..., :half], x[..., half:]
    return jnp.concatenate([x1 * cos - x2 * sin, x1 * sin + x2 * cos], axis=-1)


def dsa_attention(q, k, v, iq, ik, iw, rel_bias):
    B, S = q.shape[0], q.shape[1]
    n_top = min(TOPK_MAX, S // 4)
    nblk = S // Q_BLOCK
    grp = A_HEADS // A_KV_HEADS
    scale = A_HEAD_DIM ** -0.5
    key_chunk = jnp.arange(S) // CHUNK
    ikf = ik.astype(jnp.float32)

    def to_blocks(a):
        return a.reshape((B, nblk, Q_BLOCK) + a.shape[2:]).swapaxes(0, 1)

    def one_block(args):
        qb, iqb, iwb, blk = args
        t = blk * Q_BLOCK + jnp.arange(Q_BLOCK)
        t_chunk = t // CHUNK
        admissible = key_chunk[None, :] <= t_chunk[:, None]
        hs = jax.nn.relu(jnp.einsum('bthd,bsd->bths', iqb.astype(jnp.float32), ikf))
        score = jnp.einsum('bths,bth->bts', hs, iwb.astype(jnp.float32))
        score = jnp.where(admissible[None], score, -jnp.inf)
        _, idx = lax.top_k(score, n_top)
        valid = (idx // CHUNK) <= t_chunk[None, :, None]
        k_sel = jax.vmap(lambda kb, ib: kb[ib])(k, idx)
        v_sel = jax.vmap(lambda vb, ib: vb[ib])(v, idx)
        qg = qb.reshape(B, Q_BLOCK, A_KV_HEADS, grp, A_HEAD_DIM)
        logits = jnp.einsum('btkgd,btjkd->btkgj', qg, k_sel).astype(jnp.float32) * scale
        bias = rel_bias[t5_bucket(idx - t[None, :, None])]
        bias = bias.reshape(B, Q_BLOCK, n_top, A_KV_HEADS, grp).transpose(0, 1, 3, 4, 2)
        logits = jnp.where(valid[:, :, None, None, :], logits + bias.astype(jnp.float32), -jnp.inf)
        p = jax.nn.softmax(logits, axis=-1).astype(v.dtype)
        o = jnp.einsum('btkgj,btjkd->btkgd', p, v_sel)
        return o.reshape(B, Q_BLOCK, A_Q)

    out = lax.map(one_block, (to_blocks(q), to_blocks(iq), to_blocks(iw), jnp.arange(nblk)))
    return out.swapaxes(0, 1).reshape(B, S, A_Q)


def retention(q, k, v, g, gn_gain):
    B, S = q.shape[0], q.shape[1]
    n = S // CHUNK
    pos = jnp.arange(S, dtype=jnp.float32)
    qf = rotary(q.astype(jnp.float32), pos)
    kf = rotary(k.astype(jnp.float32), pos) * (R_HEAD_DIM ** -0.5)
    vf = v.astype(jnp.float32)
    log_g = jnp.log(1.0 - jnp.exp2(-5.0 - jnp.arange(R_HEADS, dtype=jnp.float32)))
    c = jnp.arange(CHUNK, dtype=jnp.float32)
    diff = c[:, None] - c[None, :]
    dmask = jnp.where(diff >= 0, jnp.exp(log_g[:, None, None] * jnp.maximum(diff, 0.0)), 0.0)
    xi = jnp.exp(log_g[:, None] * (c[None, :] + 1.0))
    zeta = jnp.exp(log_g[:, None] * (CHUNK - 1.0 - c[None, :]))
    g_chunk = jnp.exp(log_g * CHUNK)

    def chunks(a):
        return a.reshape(B, n, CHUNK, R_HEADS, R_HEAD_DIM).transpose(1, 0, 3, 2, 4)

    def step(state, inp):
        qc, kc, vc = inp
        att = jnp.einsum('bhid,bhjd->bhij', qc, kc) * dmask[None]
        o = (jnp.einsum('bhij,bhjd->bhid', att, vc)
             + jnp.einsum('bhid,bhde->bhie', qc, state) * xi[None, :, :, None])
        state = (state * g_chunk[None, :, None, None]
                 + jnp.einsum('bhjd,bhje->bhde', kc * zeta[None, :, :, None], vc))
        return state, o

    state0 = jnp.zeros((B, R_HEADS, R_HEAD_DIM, R_HEAD_DIM), jnp.float32)
    _, o = lax.scan(step, state0, (chunks(qf), chunks(kf), chunks(vf)))
    o = o.transpose(1, 0, 3, 2, 4).reshape(B, S, R_HEADS, R_HEAD_DIM)
    mu = jnp.mean(o, axis=-1, keepdims=True)
    var = jnp.mean(jnp.square(o - mu), axis=-1, keepdims=True)
    o = ((o - mu) * lax.rsqrt(var + GN_EPS)).reshape(B, S, R_W) * gn_gain.astype(jnp.float32)
    return (jax.nn.silu(g.astype(jnp.float32)) * o).astype(g.dtype)


def mixer(h, w_in, q_gain, k_gain, gn_gain, w_out, rel_bias):
    B, S = h.shape[0], h.shape[1]
    proj = h @ w_in
    cuts = [int(s) for s in np.cumsum(PROJ_SIZES)[:-1]]
    q, k, v, iq, ik, iw, rq, rk, rv, rg = jnp.split(proj, cuts, axis=-1)
    q = rms_norm(q.reshape(B, S, A_HEADS, A_HEAD_DIM), q_gain)
    k = rms_norm(k.reshape(B, S, A_KV_HEADS, A_HEAD_DIM), k_gain)
    v = v.reshape(B, S, A_KV_HEADS, A_HEAD_DIM)
    iq = iq.reshape(B, S, IDX_HEADS, IDX_DIM)
    a_out = dsa_attention(q, k, v, iq, ik, iw, rel_bias)
    r_out = retention(rq.reshape(B, S, R_HEADS, R_HEAD_DIM), rk.reshape(B, S, R_HEADS, R_HEAD_DIM),
                      rv.reshape(B, S, R_HEADS, R_HEAD_DIM), rg, gn_gain)
    return jnp.concatenate([a_out, r_out], axis=-1) @ w_out


def swiglu(h, w_gate, w_up, w_down):
    return (jax.nn.silu(h @ w_gate) * (h @ w_up)) @ w_down


def moe_swiglu(h, w_router, w_gate, w_up, w_down):
    B, S, D = h.shape
    xt = h.reshape(B * S, D)
    logits = (xt @ w_router).astype(jnp.float32)
    top_v, top_i = lax.top_k(logits, TOP_K)
    gk = jax.nn.softmax(top_v, axis=-1)
    gates = jnp.sum(jax.nn.one_hot(top_i, N_EXPERTS, dtype=jnp.float32) * gk[..., None], axis=1)
    out = jnp.zeros_like(xt)
    for e in range(N_EXPERTS):
        ye = swiglu(xt, w_gate[e], w_up[e], w_down[e])
        out = out + gates[:, e:e + 1].astype(xt.dtype) * ye
    return out.reshape(B, S, D)


def setup_inputs(seed: int = 0) -> dict:
    key = jax.random.key(seed)
    ks = jax.random.split(key, 16)
    f32 = jnp.float32

    def w(k, shape, fan_in):
        return jax.random.normal(k, shape, f32) * (fan_in ** -0.5)

    def gain(k, shape):
        return 1.0 + 0.02 * jax.random.normal(k, shape, f32)

    return {
        'x': jax.random.normal(ks[0], (BATCH, SEQ, D_MODEL), f32),
        'rel_bias': 0.5 * jax.random.normal(ks[1], (REL_BUCKETS, A_HEADS), f32),
        'norm_mix': gain(ks[2], (DEPTH, D_MODEL)),
        'w_in': w(ks[3], (DEPTH, D_MODEL, IN_WIDTH), D_MODEL),
        'q_gain': gain(ks[4], (DEPTH, A_HEAD_DIM)),
        'k_gain': gain(ks[5], (DEPTH, A_HEAD_DIM)),
        'ret_gain': gain(ks[6], (DEPTH, R_W)),
        'w_out': w(ks[7], (DEPTH, MIX_OUT, D_MODEL), MIX_OUT),
        'norm_ffn': gain(ks[8], (DEPTH, D_MODEL)),
        'ffn_w_gate': w(ks[9], (N_DENSE, D_MODEL, D_FF), D_MODEL),
        'ffn_w_up': w(ks[10], (N_DENSE, D_MODEL, D_FF), D_MODEL),
        'ffn_w_down': w(ks[11], (N_DENSE, D_FF, D_MODEL), D_FF),
        'moe_router': w(ks[12], (N_MOE, D_MODEL, N_EXPERTS), D_MODEL),
        'moe_w_gate': w(ks[13], (N_MOE, N_EXPERTS, D_MODEL, D_FF_EXPERT), D_MODEL),
        'moe_w_up': w(ks[14], (N_MOE, N_EXPERTS, D_MODEL, D_FF_EXPERT), D_MODEL),
        'moe_w_down': w(ks[15], (N_MOE, N_EXPERTS, D_FF_EXPERT, D_MODEL), D_FF_EXPERT),
    }


def reference(x, rel_bias, norm_mix, w_in, q_gain, k_gain, ret_gain, w_out, norm_ffn,
              ffn_w_gate, ffn_w_up, ffn_w_down, moe_router, moe_w_gate, moe_w_up, moe_w_down):
    h = x
    for l in range(DEPTH):
        h = h + mixer(rms_norm(h, norm_mix[l]), w_in[l], q_gain[l], k_gain[l], ret_gain[l],
                      w_out[l], rel_bias)
        hn = rms_norm(h, norm_ffn[l])
        j = l // 2
        if l % 2 == 0:
            h = h + swiglu(hn, ffn_w_gate[j], ffn_w_up[j], ffn_w_down[j])
        else:
            h = h + moe_swiglu(hn, moe_router[j], moe_w_gate[j], moe_w_up[j], moe_w_down[j])
    return h
```

```cpp
#include <hip/hip_runtime.h>
#include <cstdio>
#include <cstdint>

#define LAS __attribute__((address_space(3)))
#define GAS __attribute__((address_space(1)))
typedef unsigned short bf16_t;
typedef short bf16x8 __attribute__((ext_vector_type(8)));
typedef short s16x4 __attribute__((ext_vector_type(4)));
typedef float f32x2 __attribute__((ext_vector_type(2)));
typedef float f32x4 __attribute__((ext_vector_type(4)));
typedef float f32x16 __attribute__((ext_vector_type(16)));
typedef unsigned u32x2 __attribute__((ext_vector_type(2)));
typedef unsigned u32x4 __attribute__((ext_vector_type(4)));
typedef int i32x8 __attribute__((ext_vector_type(8)));
typedef int i32x4 __attribute__((ext_vector_type(4)));

constexpr int DM = 2048, NBATCH = 4, SEQ = 4096, NTOK = NBATCH * SEQ;
constexpr int AH = 8, AKV = 2, AD = 128, IH = 16, IDIM = 64, RH = 4, RD = 256;
constexpr int INW = 6736, INP = 6912;
constexpr int DFF = 5632, NE = 8, DFE = 7168;
constexpr int NLAYER = 2;
constexpr float EPS = 1e-6f, GN_EPS = 1e-5f;
constexpr float LOG2E = 1.4426950408889634f;

constexpr size_t MiB = 1u << 20;
constexpr size_t WS_CTL = 0, CTL_ZERO_BYTES = 1 * MiB;
constexpr size_t WS_SMALL = 1 * MiB;
constexpr size_t WS_ROPE = 9 * MiB;
constexpr size_t WS_W_IN = 13 * MiB, WS_W_FUP = 83 * MiB, WS_W_OUT = 67 * MiB, WS_W_FDN = 127 * MiB, WS_W_MUP = 149 * MiB, WS_W_MDN = 373 * MiB;
constexpr size_t WS_HB = 485 * MiB, WS_HB8 = 549 * MiB, WS_MASK = 581 * MiB, WS_MIX = 589 * MiB, WS_PROJ = 653 * MiB, WS_BIG = 1024 * MiB, WS_END = 1280 * MiB;
constexpr float S_HB8 = 8.f, S_WUP8 = 64.f, S_H8 = 4.f, S_WDN8 = 128.f;
constexpr size_t PJ_Q = 0, PJ_K = 32 * MiB, PJ_V = 40 * MiB, PJ_IQ = 48 * MiB, PJ_IK = 80 * MiB, PJ_IW = 82 * MiB, PJ_RG = 83 * MiB, PJ_QP = 115 * MiB,
                 PJ_SV = 179 * MiB, PJ_KT = 243 * MiB, PJ_RK = 275 * MiB, PJ_KVT = 307 * MiB;
constexpr size_t PJ_Y = 0;
constexpr size_t SM_RFAC = 2 * 1024 * 1024;
constexpr size_t SM_SA = 1024 * 1024, SM_SBIN = SM_SA + 64 * 1024, SM_SBF = SM_SBIN + 64 * 1024;
constexpr size_t SM_RSTD = 0, SM_TOKE = 64 * 1024, SM_TOKS = SM_TOKE + 128 * 1024, SM_TOKG = SM_TOKS + 128 * 1024, SM_LIST = SM_TOKG + 128 * 1024;
constexpr int CW_CNT = 64;
constexpr int CW_BAR = 4096;
constexpr int CW_QUEUE = 3072;
constexpr int CW_CMAX_IN = 16384, CW_CMAX_F = CW_CMAX_IN + 64;

typedef __bf16 bf16v2 __attribute__((ext_vector_type(2)));
__device__ __forceinline__ unsigned cvt_pk_bf16(float lo, float hi) { const f32x2 x = {lo, hi}; return __builtin_bit_cast(unsigned, __builtin_convertvector(x, bf16v2)); }
__device__ __forceinline__ unsigned cvt_pk4_fp8(float a, float b, float c, float d) { int w = __builtin_amdgcn_cvt_pk_fp8_f32(a, b, 0, false); w = __builtin_amdgcn_cvt_pk_fp8_f32(c, d, w, true); return (unsigned)w; }
__device__ __forceinline__ unsigned pk4_i8(float a, float b, float c, float d) { return ((unsigned)__float2int_rn(a) & 255u) | (((unsigned)__float2int_rn(b) & 255u) << 8) | (((unsigned)__float2int_rn(c) & 255u) << 16) | ((unsigned)__float2int_rn(d) << 24); }
__device__ __forceinline__ float bf_lo(unsigned w) { return __uint_as_float(w << 16); }
__device__ __forceinline__ float bf_hi(unsigned w) { return __uint_as_float(w & 0xffff0000u); }
__device__ __forceinline__ float wave_sum(float v) {
#pragma unroll
    for (int o = 1; o < 64; o <<= 1) v += __shfl_xor(v, o);
    return v;
}
template <class T> __device__ __forceinline__ T* as_global(T* p) { return p; }
template <class T> __device__ __forceinline__ T* launder(T* p) { __attribute__((address_space(1))) T* g = (__attribute__((address_space(1))) T*)p; asm volatile("" : "+s"(g)); return (T*)g; }
__device__ __forceinline__ int tid_l() { int t = (int)threadIdx.x; asm volatile("" : "+v"(t)); return t; }
#define LDS_WAIT() asm volatile("s_waitcnt lgkmcnt(0)" ::: "memory")
#define VM_WAIT() asm volatile("s_waitcnt vmcnt(0)" ::: "memory")

#define XB_TMO      128
#define XB_XCNT(j)  (256  + 64 * (j))
#define XB_XSUB(j)  (1280 + 64 * (j))
#define XB_XGEN(j)  (2304 + 64 * (j))
#define XB_TOP      3328
#define XB_TOPGEN   3392
#define XCD_BAR_WORDS 3456
#define XB_SPIN_CAP (1u << 22)
__device__ __forceinline__ unsigned xb_ld(unsigned* p)              { return __hip_atomic_load(p, __ATOMIC_RELAXED, __HIP_MEMORY_SCOPE_AGENT); }
__device__ __forceinline__ unsigned xb_add(unsigned* p, unsigned v) { return __hip_atomic_fetch_add(p, v, __ATOMIC_RELAXED, __HIP_MEMORY_SCOPE_AGENT); }
__device__ __forceinline__ unsigned xb_xcc_id() { return (unsigned)__builtin_amdgcn_s_getreg((3 << 11) | 20) & 0xFu; }
#define XB_SPIN(cond, bar) do { unsigned _sp = 0; while (cond) { __builtin_amdgcn_s_sleep(1); \
    if ((++_sp & 255u) == 0u) { if (xb_ld(&(bar)[XB_TMO])) break; if (_sp > XB_SPIN_CAP) { atomicAdd(&(bar)[XB_TMO], 1u); break; } } } } while (0)
struct XcdBarrier { unsigned* bar; unsigned x; volatile LAS unsigned* st; };
__device__ __forceinline__ XcdBarrier xcd_barrier_post(unsigned* bar, volatile LAS unsigned* st) {
    XcdBarrier b; b.bar = bar; b.x = xb_xcc_id(); b.st = st;
    if (threadIdx.x == 0) (void)xb_add(&bar[XB_XCNT(b.x)], 1u);
    return b;
}
__device__ __forceinline__ void xcd_barrier_complete(unsigned* bar, unsigned x, unsigned& nloc, unsigned& nx) {
    const unsigned G = gridDim.x * gridDim.y * gridDim.z;
    unsigned sum, cnt, mine, sp = 0u;
    for (;;) {
        sum = 0u; cnt = 0u; mine = 0u;
#pragma unroll
        for (unsigned j = 0; j < 16; ++j) { const unsigned c = xb_ld(&bar[XB_XCNT(j)]); sum += c; cnt += (c > 0u) ? 1u : 0u; mine = (j == x) ? c : mine; }
        if (sum == G) break;
        __builtin_amdgcn_s_sleep(1);
        if ((++sp & 255u) == 0u) { if (xb_ld(&bar[XB_TMO])) break; if (sp > XB_SPIN_CAP) { atomicAdd(&bar[XB_TMO], 1u); break; } }
    }
    nloc = mine > 0u ? mine : 1u; nx = cnt > 0u ? cnt : 1u;
}
__device__ __forceinline__ void xcd_barrier(const XcdBarrier& b) {
    asm volatile("s_waitcnt vmcnt(0)" ::: "memory");
    __syncthreads();
    if (threadIdx.x == 0) {
        unsigned* bar = launder(b.bar); unsigned bx = b.x; asm volatile("" : "+s"(bx));
        __builtin_amdgcn_s_waitcnt(0);
        unsigned nloc = b.st[0], nx = b.st[1];
        if (nloc == 0u) { xcd_barrier_complete(bar, bx, nloc, nx); b.st[0] = nloc; b.st[1] = nx; }
        const unsigned old = xb_add(&bar[XB_XSUB(bx)], 1u);
        const unsigned gen = old / nloc;
        if (old + 1u == (gen + 1u) * nloc) {
            __builtin_amdgcn_fence(__ATOMIC_RELEASE, "agent");
            asm volatile("s_waitcnt vmcnt(0)" ::: "memory");
            const unsigned og = xb_add(&bar[XB_TOP], 1u);
            const unsigned tg = og / nx;
            if (og + 1u == (tg + 1u) * nx) xb_add(&bar[XB_TOPGEN], 1u);
            else XB_SPIN(xb_ld(&bar[XB_TOPGEN]) == tg, bar);
            __builtin_amdgcn_fence(__ATOMIC_ACQUIRE, "agent");
            xb_add(&bar[XB_XGEN(bx)], 1u);
            asm volatile("s_waitcnt vmcnt(0)" ::: "memory");
        } else {
            XB_SPIN(xb_ld(&bar[XB_XGEN(bx)]) == gen, bar);
            __builtin_amdgcn_fence(__ATOMIC_ACQUIRE, "agent");
            asm volatile("s_waitcnt vmcnt(0)" ::: "memory");
        }
    }
    __syncthreads();
}

namespace gm {
constexpr int BM = 256, BK = 64, HALF = 128, HTB = HALF * BK * 2, STAGE_BYTES = 8 * HTB, NXCD = 8, WGM = 4;
__host__ __device__ __forceinline__ int lds_byte(int r, int c) { const int st = (r >> 4) * 2 + (c >> 5), rr = r & 15, cc = c & 31, ob = rr * 64 + cc * 2; return st * 1024 + (ob ^ (((ob >> 9) & 1) << 5)); }
__host__ __device__ __forceinline__ void stage_rc(int b, int& R, int& C) { const int st = b / 1024, sb = b % 1024, swz = sb ^ (((sb >> 9) & 1) << 5); R = (st >> 1) * 16 + swz / 64; C = (st & 1) * 32 + (swz % 64) / 2; }
__host__ __device__ __forceinline__ int perm32(int rho) { const int n = rho >> 4, i = rho & 15; return 8 * (i >> 2) + 4 * n + (i & 3); }

struct Unit { const char* A; const char* B; const int* rows; int pm, pn, nt, aux; };

__device__ __forceinline__ bool tile_order(long L, int nM, int nN, int& pm, int& pn) {
    const int nwg = nM * nN; if (L >= nwg) return false;
    int wgid = (int)L; { const int q = nwg / NXCD, r = nwg % NXCD, xcd = wgid % NXCD, off = wgid / NXCD; wgid = (xcd < r ? xcd * (q + 1) : r * (q + 1) + (xcd - r) * q) + off; }
    const int nig = WGM * nN, gid = wgid / nig, fm = gid * WGM, gsz = (nM - fm) < WGM ? (nM - fm) : WGM;
    pm = fm + ((wgid % nig) % gsz); pn = (wgid % nig) / gsz; return true;
}

template <class Epi, class Sched, bool GATHER, int MODE = 0>
__device__ __forceinline__ void gemm_phase(LAS unsigned char* lds, const Sched& S, const Epi& E, const unsigned lda, const unsigned ldb) {
    const int tid = tid_l(), wid = __builtin_amdgcn_readfirstlane(tid >> 6), lane = tid & 63, wr = wid >> 2, wc = wid & 3, fr = lane & 15, fq = lane >> 4;
    int Rr[2]; unsigned Cc[2], voffB[2];
#pragma unroll
    for (int i = 0; i < 2; ++i) { int R, C; stage_rc(tid * 16 + i * 8192, R, C); const int Rb = Epi::PERM ? ((R & ~31) + perm32(R & 31)) : R;
        Rr[i] = R; Cc[i] = (unsigned)C * 2u; voffB[i] = (unsigned)Rb * ldb + (unsigned)C * 2u; }
    const size_t kstep = (size_t)(BK * 2);
    const size_t hstepB = (size_t)HALF * ldb, hstepA = GATHER ? 0 : (size_t)HALF * lda;
    const unsigned ldsw = (unsigned)wid * 1024u;
    const int aoff = lds_byte(wr * 64 + fr, fq * 8), boff = lds_byte(wc * 32 + fr, fq * 8);
#define GM_SA(b, h) (((b) * 2 + (h)) * HTB)
#define GM_SB(b, h) ((4 + (b) * 2 + (h)) * HTB)
#define GM_STAGE_A(bufoff, gbase, offs) do { _Pragma("unroll") for (int _i = 0; _i < 2; ++_i) \
        __builtin_amdgcn_global_load_lds((const unsigned*)((const char*)(gbase) + (offs)[_i]), (LAS unsigned*)(lds + (bufoff) + ldsw + _i * 8192), 16, 0, 0); } while (0)
#define GM_STAGE_B(bufoff, gbase) do { _Pragma("unroll") for (int _i = 0; _i < 2; ++_i) \
        __builtin_amdgcn_global_load_lds((const unsigned*)((const char*)(gbase) + voffB[_i]), (LAS unsigned*)(lds + (bufoff) + ldsw + _i * 8192), 16, 0, 0); } while (0)
#define GM_LDA(dst, b, h) do { _Pragma("unroll") for (int m = 0; m < 4; ++m) _Pragma("unroll") for (int k = 0; k < 2; ++k) dst[m][k] = *(const LAS bf16x8*)(lds + GM_SA(b, h) + aoff + m * 2048 + k * 1024); } while (0)
#define GM_LDB(dst, b, h) do { _Pragma("unroll") for (int n = 0; n < 2; ++n) _Pragma("unroll") for (int k = 0; k < 2; ++k) dst[n][k] = *(const LAS bf16x8*)(lds + GM_SB(b, h) + boff + n * 2048 + k * 1024); } while (0)
#define GM_MMA(ai, bj, At, Bt) do { __builtin_amdgcn_s_setprio(1); _Pragma("unroll") for (int m = 0; m < 4; ++m) _Pragma("unroll") for (int n = 0; n < 2; ++n) { \
        if constexpr (MODE == 1) { const i32x8 b8_ = __builtin_shufflevector(__builtin_bit_cast(i32x4, Bt[n][0]), __builtin_bit_cast(i32x4, Bt[n][1]), 0, 1, 2, 3, 4, 5, 6, 7); \
            const i32x8 a8_ = __builtin_shufflevector(__builtin_bit_cast(i32x4, At[m][0]), __builtin_bit_cast(i32x4, At[m][1]), 0, 1, 2, 3, 4, 5, 6, 7); \
            asm volatile("v_mfma_scale_f32_16x16x128_f8f6f4 %0, %1, %2, %0, %3, %3 op_sel_hi:[0,0,0]" : "+v"(acc[ai][bj][m][n]) : "v"(b8_), "v"(a8_), "v"(sc1_)); } \
        else if constexpr (MODE == 2) { i32x4 ci_ = __builtin_bit_cast(i32x4, acc[ai][bj][m][n]); \
            _Pragma("unroll") for (int k = 0; k < 2; ++k) ci_ = __builtin_amdgcn_mfma_i32_16x16x64_i8(__builtin_bit_cast(i32x4, Bt[n][k]), __builtin_bit_cast(i32x4, At[m][k]), ci_, 0, 0, 0); \
            acc[ai][bj][m][n] = __builtin_bit_cast(f32x4, ci_); } \
        else { _Pragma("unroll") for (int k = 0; k < 2; ++k) acc[ai][bj][m][n] = __builtin_amdgcn_mfma_f32_16x16x32_bf16(Bt[n][k], At[m][k], acc[ai][bj][m][n], 0, 0, 0); } } \
        __builtin_amdgcn_s_setprio(0); } while (0)
#define GM_WAIT_V(n) asm volatile("s_waitcnt vmcnt(" #n ")" ::: "memory")
#define GM_WAIT_L(n) asm volatile("s_waitcnt lgkmcnt(" #n ")" ::: "memory")
#define GM_BAR __builtin_amdgcn_s_barrier()
#define GM_SCHED __builtin_amdgcn_sched_barrier(0)
    Unit cur, nxt; int ui = 0;
    if (!S.next(0, cur)) return;
    f32x4 acc[2][2][4][2];
#pragma unroll
    for (int a = 0; a < 2; ++a)
#pragma unroll
        for (int b = 0; b < 2; ++b)
#pragma unroll
            for (int m = 0; m < 4; ++m)
#pragma unroll
                for (int n = 0; n < 2; ++n) acc[a][b][m][n] = (f32x4){0.f, 0.f, 0.f, 0.f};
    bf16x8 At[4][2], B0[2][2], B1[2][2];
    const int sc1_ = 0x7F7F7F7F; (void)sc1_;
    unsigned aoC[2][2], aoN[2][2]; int rowN[2][2];
#pragma unroll
    for (int h = 0; h < 2; ++h)
#pragma unroll
        for (int i = 0; i < 2; ++i) { const int row = h * HALF + Rr[i]; const int rr = GATHER ? cur.rows[row] : Rr[i]; aoC[h][i] = (unsigned)rr * lda + Cc[i]; aoN[h][i] = aoC[h][i]; rowN[h][i] = 0; }
    const char* cA = cur.A; const char* cB = cur.B;
    GM_STAGE_B(GM_SB(0, 0), cB); GM_STAGE_B(GM_SB(0, 1), cB + hstepB); GM_STAGE_A(GM_SA(0, 0), cA, aoC[0]); GM_STAGE_A(GM_SA(0, 1), cA + hstepA, aoC[1]);
    if (wr == 1) GM_BAR;
    GM_WAIT_V(2); GM_BAR;
    GM_STAGE_B(GM_SB(1, 0), cB + kstep); GM_STAGE_A(GM_SA(1, 0), cA + kstep, aoC[0]); GM_STAGE_B(GM_SB(1, 1), cB + hstepB + kstep);
    GM_WAIT_V(6); GM_BAR;
    for (;;) {
        const bool has_next = S.next(ui + 1, nxt);
        const char* nA = has_next ? nxt.A : cA; const char* nB = has_next ? nxt.B : cB;
        if constexpr (GATHER) { if (has_next) {
#pragma unroll
            for (int h = 0; h < 2; ++h)
#pragma unroll
                for (int i = 0; i < 2; ++i) rowN[h][i] = nxt.rows[h * HALF + Rr[i]]; } }
        const int nt = cur.nt;
        for (int t = 0; t < nt; t += 2) {
            const bool last = (t == nt - 2);
            const char* a1 = cA + (size_t)(t + 1) * kstep;
            const char* a2 = last ? nA : cA + (size_t)(t + 2) * kstep; const char* b2 = last ? nB : cB + (size_t)(t + 2) * kstep;
            const char* a3 = a2 + kstep; const char* b3 = b2 + kstep;
            unsigned o2[2][2];
            if constexpr (GATHER) {
                if (last && has_next) {
#pragma unroll
                    for (int h = 0; h < 2; ++h)
#pragma unroll
                        for (int i = 0; i < 2; ++i) aoN[h][i] = (unsigned)rowN[h][i] * lda + Cc[i];
                }
#pragma unroll
                for (int h = 0; h < 2; ++h)
#pragma unroll
                    for (int i = 0; i < 2; ++i) o2[h][i] = last ? aoN[h][i] : aoC[h][i];
            } else {
#pragma unroll
                for (int h = 0; h < 2; ++h)
#pragma unroll
                    for (int i = 0; i < 2; ++i) o2[h][i] = aoC[0][i];
            }
            GM_LDB(B0, 0, 0); GM_LDB(B1, 0, 1); GM_SCHED; GM_LDA(At, 0, 0); GM_STAGE_A(GM_SA(1, 1), a1 + hstepA, aoC[1]);
            GM_WAIT_V(8); GM_WAIT_L(0); GM_BAR; GM_MMA(0, 0, At, B0); GM_MMA(0, 1, At, B1); GM_BAR; GM_SCHED;
            GM_LDA(At, 0, 1); GM_STAGE_B(GM_SB(0, 0), b2); GM_STAGE_B(GM_SB(0, 1), b2 + hstepB); GM_STAGE_A(GM_SA(0, 0), a2, o2[0]);
            GM_WAIT_V(8); GM_WAIT_L(0); GM_BAR; GM_MMA(1, 0, At, B0); GM_MMA(1, 1, At, B1); GM_BAR; GM_SCHED;
            GM_LDB(B0, 1, 0); GM_LDB(B1, 1, 1); GM_SCHED; GM_LDA(At, 1, 0); GM_STAGE_A(GM_SA(0, 1), a2 + hstepA, o2[1]);
            GM_WAIT_V(8); GM_WAIT_L(0); GM_BAR; GM_MMA(0, 0, At, B0); GM_MMA(0, 1, At, B1); GM_BAR; GM_SCHED;
            GM_LDA(At, 1, 1); GM_STAGE_B(GM_SB(1, 0), b3); GM_STAGE_B(GM_SB(1, 1), b3 + hstepB); GM_STAGE_A(GM_SA(1, 0), a3, o2[0]);
            GM_WAIT_V(8); GM_WAIT_L(0); GM_BAR; GM_MMA(1, 0, At, B0); GM_MMA(1, 1, At, B1); GM_BAR; GM_SCHED;
        }
        if (wr == 0) GM_BAR;
        if constexpr (MODE == 1) asm volatile("s_nop 7\n\ts_nop 7\n\ts_nop 7" ::: "memory");
        E(acc, cur, wr, wc, fr, fq);
        if (!has_next) break;
#pragma unroll
        for (int a = 0; a < 2; ++a)
#pragma unroll
            for (int b = 0; b < 2; ++b)
#pragma unroll
                for (int m = 0; m < 4; ++m)
#pragma unroll
                    for (int n = 0; n < 2; ++n) acc[a][b][m][n] = (f32x4){0.f, 0.f, 0.f, 0.f};
        cur = nxt; cA = nA; cB = nB; ++ui;
        if constexpr (GATHER) {
#pragma unroll
            for (int h = 0; h < 2; ++h)
#pragma unroll
                for (int i = 0; i < 2; ++i) aoC[h][i] = aoN[h][i];
        }
        if (wr == 1) GM_BAR;
    }
    GM_WAIT_V(0);
    GM_BAR;
#undef GM_SA
#undef GM_SB
#undef GM_STAGE_A
#undef GM_STAGE_B
#undef GM_LDA
#undef GM_LDB
#undef GM_MMA
#undef GM_WAIT_V
#undef GM_WAIT_L
#undef GM_BAR
#undef GM_SCHED
}
}

typedef f32x4 Acc[2][2][4][2];
__device__ __forceinline__ u32x4 pack8(const f32x4 a, const f32x4 b) { u32x4 w; w.x = cvt_pk_bf16(a[0], a[1]); w.y = cvt_pk_bf16(a[2], a[3]); w.z = cvt_pk_bf16(b[0], b[1]); w.w = cvt_pk_bf16(b[2], b[3]); return w; }
__device__ __forceinline__ float silu_f(float g) { return g * __builtin_amdgcn_rcpf(1.0f + __builtin_amdgcn_exp2f(-g * LOG2E)); }

template <bool I8> __device__ __forceinline__ f32x4 accv(const f32x4& a) {
    if constexpr (I8) { const i32x4 i = __builtin_bit_cast(i32x4, a); return (f32x4){(float)i[0], (float)i[1], (float)i[2], (float)i[3]}; } else return a; }

struct SchedDense {
    const char* A; const char* B; unsigned lda, ldb; int nM, nN, nt, G, c;
    __device__ __forceinline__ bool next(int i, gm::Unit& u) const {
        int pm, pn; if (!gm::tile_order((long)i * G + c, nM, nN, pm, pn)) return false;
        u.pm = pm; u.pn = pn; u.nt = nt; u.aux = 0; u.rows = nullptr;
        u.A = A + (size_t)pm * 256 * lda; u.B = B + (size_t)pn * 256 * ldb; return true;
    }
};

template <bool I8> struct EpiInProj {
    static constexpr bool PERM = true;
    unsigned char* pj; const float* rstd; const float* ropec; const float* ropes; const float* sa; const float* sb;
    __device__ __forceinline__ void operator()(const Acc& acc, const gm::Unit& u, int wr, int wc, int fr, int fq) const {
        int frl = fr, fql = fq; asm volatile("" : "+v"(frl), "+v"(fql));
        const int pn = u.pn, row0 = u.pm * 256 + wr * 64 + frl, cw = wc * 32 + 8 * fql;
        float rs[2][4];
#pragma unroll
        for (int ai = 0; ai < 2; ++ai)
#pragma unroll
            for (int m = 0; m < 4; ++m) { const int row = row0 + ai * 128 + m * 16; rs[ai][m] = I8 ? rstd[row] * sa[row] * sb[pn] : rstd[row]; }
#define AV(ai, bj, m, n) accv<I8>(acc[ai][bj][m][n])
        if (pn == 10) {
            bf16_t* ik = (bf16_t*)(pj + PJ_IK); float* iw = (float*)(pj + PJ_IW);
#pragma unroll
            for (int ai = 0; ai < 2; ++ai)
#pragma unroll
                for (int m = 0; m < 4; ++m) { const int row = row0 + ai * 128 + m * 16; const float r = rs[ai][m];
                    if (wc < 2) *(u32x4*)(ik + (size_t)row * 64 + cw) = pack8(AV(ai, 0, m, 0) * r, AV(ai, 0, m, 1) * r);
                    else if (wc == 2 && fq < 2) { *(f32x4*)(iw + (size_t)row * 16 + 8 * fq) = AV(ai, 0, m, 0) * r; *(f32x4*)(iw + (size_t)row * 16 + 8 * fq + 4) = AV(ai, 0, m, 1) * r; } }
            return;
        }
        if (pn >= 11 && pn < 19) {
            const bool isk = pn >= 15; const int h = isk ? pn - 15 : pn - 11; const size_t tile = (size_t)u.pm * 4 + h;
            const float lg2 = __builtin_log2f(1.0f - __builtin_exp2f(-5.0f - (float)h));
            bf16_t* qp = (bf16_t*)(pj + PJ_QP) + tile * 256 * 512; bf16_t* rk = (bf16_t*)(pj + PJ_RK) + h * 256; bf16_t* kt = (bf16_t*)(pj + PJ_KT) + tile * 256 * 256;
#pragma unroll
            for (int ai = 0; ai < 2; ++ai)
#pragma unroll
                for (int m = 0; m < 4; ++m) { const int row = row0 + ai * 128 + m * 16, pos = row & (SEQ - 1), i = row & 255;
                    const float r = rs[ai][m] * (isk ? 0.0625f * __builtin_amdgcn_exp2f(lg2 * (float)(255 - i)) : __builtin_amdgcn_exp2f(lg2 * (float)(i + 1)));
                    const f32x4 c0 = *(const f32x4*)(ropec + pos * 128 + cw), c1 = *(const f32x4*)(ropec + pos * 128 + cw + 4);
                    const f32x4 s0 = *(const f32x4*)(ropes + pos * 128 + cw), s1 = *(const f32x4*)(ropes + pos * 128 + cw + 4);
                    const f32x4 x10 = AV(ai, 0, m, 0) * r, x11 = AV(ai, 0, m, 1) * r, x20 = AV(ai, 1, m, 0) * r, x21 = AV(ai, 1, m, 1) * r;
                    const u32x4 w1 = pack8(x10 * c0 - x20 * s0, x11 * c1 - x21 * s1), w2 = pack8(x10 * s0 + x20 * c0, x11 * s1 + x21 * c1);
                    if (!isk) { bf16_t* rowp = qp + (size_t)i * 512 + cw; *(u32x4*)(rowp) = w1; *(u32x4*)(rowp + 128) = w2; }
                    else { bf16_t* rowp = rk + (size_t)row * 1024 + cw; *(u32x4*)(rowp) = w1; *(u32x4*)(rowp + 128) = w2;
                        bf16_t* tp = kt + (size_t)cw * 256 + i;
#pragma unroll
                        for (int q = 0; q < 4; ++q) { tp[(2 * q) * 256] = (bf16_t)(w1[q] & 0xffffu); tp[(2 * q + 1) * 256] = (bf16_t)(w1[q] >> 16);
                                                      tp[(128 + 2 * q) * 256] = (bf16_t)(w2[q] & 0xffffu); tp[(128 + 2 * q + 1) * 256] = (bf16_t)(w2[q] >> 16); } }
                    asm volatile("" ::: "memory"); }
            return;
        }
        if (pn >= 19 && pn < 23) {
            const int h = pn - 19; const size_t tile = (size_t)u.pm * 4 + h; bf16_t* sv = (bf16_t*)(pj + PJ_SV) + tile * 256 * 512 + 256;
#pragma unroll
            for (int ai = 0; ai < 2; ++ai)
#pragma unroll
                for (int m = 0; m < 4; ++m) { const int row = row0 + ai * 128 + m * 16, i = row & 255; const float r = rs[ai][m];
#pragma unroll
                    for (int bj = 0; bj < 2; ++bj) { const u32x4 w = pack8(AV(ai, bj, m, 0) * r, AV(ai, bj, m, 1) * r); bf16_t* tp = sv + (size_t)(bj * 128 + cw) * 512 + i;
#pragma unroll
                        for (int q = 0; q < 4; ++q) { tp[(2 * q) * 512] = (bf16_t)(w[q] & 0xffffu); tp[(2 * q + 1) * 512] = (bf16_t)(w[q] >> 16); } }
                    asm volatile("" ::: "memory"); }
            return;
        }
        bf16_t* dst; int ld;
        if (pn < 4) { dst = (bf16_t*)(pj + PJ_Q) + pn * 256; ld = 1024; }
        else if (pn == 4) { dst = (bf16_t*)(pj + PJ_K); ld = 256; }
        else if (pn == 5) { dst = (bf16_t*)(pj + PJ_V); ld = 256; }
        else if (pn < 10) { dst = (bf16_t*)(pj + PJ_IQ) + (pn - 6) * 256; ld = 1024; }
        else { dst = (bf16_t*)(pj + PJ_RG) + (pn - 23) * 256; ld = 1024; }
#pragma unroll
        for (int ai = 0; ai < 2; ++ai)
#pragma unroll
            for (int m = 0; m < 4; ++m) { const int row = row0 + ai * 128 + m * 16; const float r = rs[ai][m]; bf16_t* rowp = dst + (size_t)row * ld + cw;
#pragma unroll
                for (int bj = 0; bj < 2; ++bj) *(u32x4*)(rowp + bj * 128) = pack8(AV(ai, bj, m, 0) * r, AV(ai, bj, m, 1) * r); }
    }
};
#undef AV

struct EpiResid {
    static constexpr bool PERM = false;
    const float* src; float* dst; bf16_t* hb;
    __device__ __forceinline__ void operator()(const Acc& acc, const gm::Unit& u, int wr, int wc, int fr, int fq) const {
        const int row0 = u.pm * 256 + wr * 64 + fr, col0 = u.pn * 256 + wc * 32 + 4 * fq;
#pragma unroll
        for (int ai = 0; ai < 2; ++ai)
#pragma unroll
            for (int m = 0; m < 4; ++m) { const size_t off = (size_t)(row0 + ai * 128 + m * 16) * DM + col0;
#pragma unroll
                for (int bj = 0; bj < 2; ++bj)
#pragma unroll
                    for (int n = 0; n < 2; ++n) { const f32x4 b = *(const f32x4*)(src + off + bj * 128 + n * 16); const f32x4 o = b + acc[ai][bj][m][n]; *(f32x4*)(dst + off + bj * 128 + n * 16) = o;
                        u32x2 w; w.x = cvt_pk_bf16(o[0], o[1]); w.y = cvt_pk_bf16(o[2], o[3]); *(u32x2*)(hb + off + bj * 128 + n * 16) = w; }
                asm volatile("" ::: "memory"); }
    }
};

template <bool I8> struct EpiFfnUp {
    static constexpr bool PERM = true;
    bf16_t* H; const float* rstd; const float* sa; const float* sb;
    __device__ __forceinline__ void operator()(const Acc& acc, const gm::Unit& u, int wr, int wc, int fr, int fq) const {
        const int row0 = u.pm * 256 + wr * 64 + fr, col0 = u.pn * 128 + wc * 32 + 8 * fq;
#pragma unroll
        for (int ai = 0; ai < 2; ++ai)
#pragma unroll
            for (int m = 0; m < 4; ++m) { const int row = row0 + ai * 128 + m * 16; const float r = I8 ? rstd[row] * sa[row] * sb[u.pn] : rstd[row]; f32x4 o[2];
#pragma unroll
                for (int n = 0; n < 2; ++n) { const f32x4 g4 = accv<I8>(acc[ai][0][m][n]), u4 = accv<I8>(acc[ai][1][m][n]);
#pragma unroll
                    for (int e = 0; e < 4; ++e) o[n][e] = silu_f(g4[e] * r) * (u4[e] * r); }
                *(u32x4*)(H + (size_t)row * DFF + col0) = pack8(o[0], o[1]); asm volatile("" ::: "memory"); }
    }
};

struct SchedRetTile {
    const char* A; const char* B; size_t strideA, strideB; int nt, G, c, bstep_row;
    __device__ __forceinline__ bool next(int i, gm::Unit& u) const {
        const int L = i * G + c; if (L >= 256) return false;
        u.pm = L >> 2; u.pn = 0; u.nt = nt; u.aux = L; u.rows = nullptr;
        u.A = A + (size_t)L * strideA; u.B = bstep_row ? B + (size_t)(L >> 2) * bstep_row + (size_t)(L & 3) * 512 : B + (size_t)L * strideB; return true;
    }
};
struct EpiRetP {
    static constexpr bool PERM = true;
    bf16_t* QP;
    __device__ __forceinline__ void operator()(const Acc& acc, const gm::Unit& u, int wr, int wc, int fr, int fq) const {
        const int h = u.aux & 3; const float gi = __builtin_amdgcn_exp2f(-256.0f * __builtin_log2f(1.0f - __builtin_exp2f(-5.0f - (float)h)));
        bf16_t* Pb = QP + (size_t)u.aux * 256 * 512 + 256;
        int t0 = wr * 64 + fr; const int s0 = wc * 32 + 8 * fq; asm volatile("" : "+v"(t0));
#pragma unroll
        for (int ai = 0; ai < 2; ++ai)
#pragma unroll
            for (int m = 0; m < 4; ++m) { const int t = t0 + ai * 128 + m * 16;
#pragma unroll
                for (int bj = 0; bj < 2; ++bj) { const int d0 = t - (s0 + bj * 128); f32x4 o[2];
#pragma unroll
                    for (int n = 0; n < 2; ++n)
#pragma unroll
                        for (int e = 0; e < 4; ++e) o[n][e] = (d0 - (4 * n + e) >= 0) ? acc[ai][bj][m][n][e] * gi : 0.f;
                    *(u32x4*)(Pb + (size_t)t * 512 + s0 + bj * 128) = pack8(o[0], o[1]); }
                asm volatile("" ::: "memory"); }
    }
};
struct EpiRetKV {
    static constexpr bool PERM = false;
    float* KVT;
    __device__ __forceinline__ void operator()(const Acc& acc, const gm::Unit& u, int wr, int wc, int fr, int fq) const {
        float* base = KVT + (size_t)u.aux * 65536; const int row0 = wr * 64 + fr, col0 = wc * 32 + 4 * fq;
#pragma unroll
        for (int ai = 0; ai < 2; ++ai)
#pragma unroll
            for (int m = 0; m < 4; ++m) { float* rowp = base + (size_t)(row0 + ai * 128 + m * 16) * 256 + col0;
#pragma unroll
                for (int bj = 0; bj < 2; ++bj)
#pragma unroll
                    for (int n = 0; n < 2; ++n) *(f32x4*)(rowp + bj * 128 + n * 16) = acc[ai][bj][m][n];
                asm volatile("" ::: "memory"); }
    }
};
struct EpiRetOut {
    static constexpr bool PERM = true;
    bf16_t* mix; const bf16_t* rg; const float* gn; LAS unsigned char* xl;
    __device__ __forceinline__ void operator()(const Acc& acc, const gm::Unit& u, int wr, int wc, int fr, int fq) const {
        const int tile = u.aux, h = tile & 3; LAS f32x2* P = (LAS f32x2*)xl;
        const int lr0 = wr * 64 + fr;
#pragma unroll
        for (int ai = 0; ai < 2; ++ai)
#pragma unroll
            for (int m = 0; m < 4; ++m) { float s1 = 0.f, s2 = 0.f;
#pragma unroll
                for (int bj = 0; bj < 2; ++bj)
#pragma unroll
                    for (int n = 0; n < 2; ++n) { const f32x4 x = acc[ai][bj][m][n]; s1 += (x[0] + x[1]) + (x[2] + x[3]); s2 += (x[0] * x[0] + x[1] * x[1]) + (x[2] * x[2] + x[3] * x[3]); }
                s1 += __shfl_xor(s1, 16); s1 += __shfl_xor(s1, 32); s2 += __shfl_xor(s2, 16); s2 += __shfl_xor(s2, 32);
                if (fq == 0) P[(lr0 + ai * 128 + m * 16) * 4 + wc] = (f32x2){s1, s2}; }
        asm volatile("s_waitcnt lgkmcnt(0)" ::: "memory"); __builtin_amdgcn_s_barrier(); asm volatile("" ::: "memory");
        const size_t grow0 = (size_t)(tile >> 2) * 256; const int cw = wc * 32 + 8 * fq;
#pragma unroll
        for (int ai = 0; ai < 2; ++ai)
#pragma unroll
            for (int m = 0; m < 4; ++m) { const int lr = lr0 + ai * 128 + m * 16;
                const f32x4 pa = *(const LAS f32x4*)(P + lr * 4), pb = *(const LAS f32x4*)(P + lr * 4 + 2);
                const float S = (pa[0] + pa[2]) + (pb[0] + pb[2]), Q = (pa[1] + pa[3]) + (pb[1] + pb[3]);
                const float mu = S * (1.0f / RD), var = Q * (1.0f / RD) - mu * mu, r = 1.0f / sqrtf(fmaxf(var, 0.f) + GN_EPS);
                const size_t goff = (grow0 + lr) * 1024 + h * 256 + cw;
#pragma unroll
                for (int bj = 0; bj < 2; ++bj) { const u32x4 gw = *(const u32x4*)(rg + goff + bj * 128);
                    const f32x4 g0 = *(const f32x4*)(gn + h * 256 + bj * 128 + cw), g1 = *(const f32x4*)(gn + h * 256 + bj * 128 + cw + 4);
                    f32x4 o0, o1;
#pragma unroll
                    for (int e = 0; e < 4; ++e) { const float ga = (e & 1) ? bf_hi(gw[e >> 1]) : bf_lo(gw[e >> 1]), gb = (e & 1) ? bf_hi(gw[2 + (e >> 1)]) : bf_lo(gw[2 + (e >> 1)]);
                        o0[e] = silu_f(ga) * (acc[ai][bj][m][0][e] - mu) * r * g0[e]; o1[e] = silu_f(gb) * (acc[ai][bj][m][1][e] - mu) * r * g1[e]; }
                    *(u32x4*)(mix + (grow0 + lr) * DM + 1024 + h * 256 + bj * 128 + cw) = pack8(o0, o1); }
                asm volatile("" ::: "memory"); }
    }
};

struct MoeInfo { int toff[NE + 1]; };
__device__ __forceinline__ MoeInfo moe_info(const unsigned* ctl) {
    MoeInfo mi; int t = 0;
#pragma unroll
    for (int e = 0; e < NE; ++e) { mi.toff[e] = t; const int c = (int)__builtin_amdgcn_readfirstlane((int)ctl[CW_CNT + 64 * e]); t += (c + 255) >> 8; }
    mi.toff[NE] = t; return mi;
}
__device__ __forceinline__ int moe_expert(const MoeInfo& mi, int pm, int& lt) { int e = 0; lt = pm;
#pragma unroll
    for (int j = 1; j < NE; ++j) { const bool ge = pm >= mi.toff[j]; e += ge ? 1 : 0; lt = ge ? pm - mi.toff[j] : lt; }
    return e; }
struct SchedMoeUp {
    MoeInfo mi; const char* hb; const char* W; const int* list; int G, c;
    __device__ __forceinline__ bool next(int i, gm::Unit& u) const {
        int pm, pn; if (!gm::tile_order((long)i * G + c, mi.toff[NE], DFE / 128, pm, pn)) return false;
        int lt; const int e = moe_expert(mi, pm, lt);
        u.pm = pm; u.pn = pn; u.nt = DM / 128; u.aux = e; u.rows = list + e * NTOK + lt * 256;
        u.A = hb; u.B = W + ((size_t)e * (2 * DFE) + pn * 256) * DM; return true;
    }
};
struct EpiMoeUp {
    static constexpr bool PERM = true;
    unsigned char* H; const float* rfac; const int* list;
    __device__ __forceinline__ void operator()(const Acc& acc, const gm::Unit& u, int wr, int wc, int fr, int fq) const {
        const int lr0 = wr * 64 + fr, col0 = u.pn * 128 + wc * 32 + 8 * fq; const float* rf = rfac + (u.rows - list);
#pragma unroll
        for (int ai = 0; ai < 2; ++ai)
#pragma unroll
            for (int m = 0; m < 4; ++m) { const int lr = lr0 + ai * 128 + m * 16; const float r = rf[lr] * (1.0f / (S_HB8 * S_WUP8)); f32x4 o[2];
#pragma unroll
                for (int n = 0; n < 2; ++n)
#pragma unroll
                    for (int e = 0; e < 4; ++e) o[n][e] = silu_f(acc[ai][0][m][n][e] * r) * (acc[ai][1][m][n][e] * r) * S_H8;
                u32x2 w; w.x = cvt_pk4_fp8(o[0][0], o[0][1], o[0][2], o[0][3]); w.y = cvt_pk4_fp8(o[1][0], o[1][1], o[1][2], o[1][3]);
                *(u32x2*)(H + (size_t)(u.pm * 256 + lr) * DFE + col0) = w; asm volatile("" ::: "memory"); }
    }
};
struct SchedMoeDown {
    MoeInfo mi; const char* H; const char* W; int G, c;
    __device__ __forceinline__ bool next(int i, gm::Unit& u) const {
        int pm, pn; if (!gm::tile_order((long)i * G + c, mi.toff[NE], DM / 256, pm, pn)) return false;
        int lt; const int e = moe_expert(mi, pm, lt);
        u.pm = pm; u.pn = pn; u.nt = DFE / 128; u.aux = e; u.rows = nullptr;
        u.A = H + (size_t)pm * 256 * DFE; u.B = W + ((size_t)e * DM + pn * 256) * DFE; return true;
    }
};
struct EpiMoeDown {
    static constexpr bool PERM = true;
    bf16_t* Y;
    __device__ __forceinline__ void operator()(const Acc& acc, const gm::Unit& u, int wr, int wc, int fr, int fq) const {
        const int row0 = u.pm * 256 + wr * 64 + fr, col0 = u.pn * 256 + wc * 32 + 8 * fq;
#pragma unroll
        for (int ai = 0; ai < 2; ++ai)
#pragma unroll
            for (int m = 0; m < 4; ++m) { bf16_t* rowp = Y + (size_t)(row0 + ai * 128 + m * 16) * DM + col0;
#pragma unroll
                for (int bj = 0; bj < 2; ++bj) *(u32x4*)(rowp + bj * 128) = pack8(acc[ai][bj][m][0] * (1.0f / (S_H8 * S_WDN8)), acc[ai][bj][m][1] * (1.0f / (S_H8 * S_WDN8))); }
    }
};

struct Args { const float* in[16]; float* out; unsigned char* ws; int ph_lo, ph_hi, use_bar, pad; };
typedef const __attribute__((address_space(4))) Args* KArgs;
__device__ __forceinline__ KArgs kargs() { KArgs p = (KArgs)__builtin_amdgcn_kernarg_segment_ptr(); asm volatile("" : "+s"(p)); return p; }
#define KIN(i) (as_global((const float*)kargs()->in[i]))
#define KOUT (as_global((float*)kargs()->out))
struct Ctx {
    LAS unsigned char* lds;
    unsigned char* ws; unsigned* ctl;
    int wave, G, gw, NGW, bx;
};


template <int OUT>
__device__ __forceinline__ void conv_item(const float* src0, const float* src1, int Nsrc, const float* gain, void* dstv, int Kdim, int mode, int d0, int k0, LAS float* scr, int lane, float wscale) {
    constexpr bool F8 = OUT == 1;
    const int d = d0 + lane; const float* src = src0; int col = d; bool valid = true;
    if (mode == 1) { if (d >= 2816) col = d - 176; else if (d >= 2560) valid = (d - 2560) < 80; }
    else if (mode == 2) { const int t = d >> 8, bj = (d >> 7) & 1, cc = d & 127; src = bj ? src1 : src0; col = 128 * t + cc; }
    const float* p = src + (size_t)k0 * Nsrc + col;
    float vv[64];
#pragma unroll
    for (int kk = 0; kk < 64; ++kk) vv[kk] = valid ? p[(size_t)kk * Nsrc] : 0.f;
    float qs = 1.f;
    if constexpr (OUT == 2) qs = wscale;
#pragma unroll
    for (int k16 = 0; k16 < 4; ++k16) {
#pragma unroll
        for (int k2 = 0; k2 < 16; ++k2) { const int kk = 16 * k16 + k2; float v = vv[kk]; if (gain) v *= gain[k0 + kk]; if (F8) v *= wscale; if (OUT == 2) v *= qs; scr[kk * 65 + lane] = v; }
        asm volatile("" ::: "memory"); }
    LDS_WAIT(); asm volatile("" ::: "memory");
    const int c = lane & 7;
#pragma unroll
    for (int j = 0; j < 8; ++j) { const int n = (lane >> 3) + 8 * j; const LAS float* s = scr + (8 * c) * 65 + n;
        if constexpr (OUT == 2) { u32x2 o; o.x = pk4_i8(s[0 * 65], s[1 * 65], s[2 * 65], s[3 * 65]); o.y = pk4_i8(s[4 * 65], s[5 * 65], s[6 * 65], s[7 * 65]);
            *(u32x2*)((unsigned char*)dstv + (size_t)(d0 + n) * Kdim + k0 + 8 * c) = o; }
        else if constexpr (F8) { u32x2 o; o.x = cvt_pk4_fp8(s[0 * 65], s[1 * 65], s[2 * 65], s[3 * 65]); o.y = cvt_pk4_fp8(s[4 * 65], s[5 * 65], s[6 * 65], s[7 * 65]);
            *(u32x2*)((unsigned char*)dstv + (size_t)(d0 + n) * Kdim + k0 + 8 * c) = o; }
        else { u32x4 o; o.x = cvt_pk_bf16(s[0 * 65], s[1 * 65]); o.y = cvt_pk_bf16(s[2 * 65], s[3 * 65]); o.z = cvt_pk_bf16(s[4 * 65], s[5 * 65]); o.w = cvt_pk_bf16(s[6 * 65], s[7 * 65]);
            *(u32x4*)((bf16_t*)dstv + (size_t)(d0 + n) * Kdim + k0 + 8 * c) = o; } }
    LDS_WAIT(); asm volatile("" ::: "memory");
}
template <int OUT = 0>
__device__ __forceinline__ void conv_job(int lane, int r, const float* s0, const float* s1, int Nsrc, const float* gain, void* dst, int Kdim, int Ndst, int mode, LAS float* scr, float wscale = 1.f) {
    const int ndb = Ndst / 64, kb = r / ndb, db = r % ndb;
    conv_item<OUT>(s0, s1, Nsrc, gain, dst, Kdim, mode, db * 64, kb * 64, scr, lane, wscale);
}
__device__ __forceinline__ float wmax_item(const float* src0, const float* src1, int Nsrc, const float* gain, int mode, int d0, int k0, int lane) {
    const int d = d0 + lane; const float* src = src0; int col = d; bool valid = true;
    if (mode == 1) { if (d >= 2816) col = d - 176; else if (d >= 2560) valid = (d - 2560) < 80; }
    else if (mode == 2) { const int t = d >> 8, bj = (d >> 7) & 1, cc = d & 127; src = bj ? src1 : src0; col = 128 * t + cc; }
    const float* p = src + (size_t)k0 * Nsrc + col; float mx = 0.f;
    if (valid) {
#pragma unroll 1
        for (int k64 = 0; k64 < 256; k64 += 64) { float t[64];
#pragma unroll
            for (int kk = 0; kk < 64; ++kk) t[kk] = p[(size_t)(k64 + kk) * Nsrc];
#pragma unroll
            for (int k16 = 0; k16 < 4; ++k16) {
#pragma unroll
                for (int k2 = 0; k2 < 16; ++k2) mx = fmaxf(mx, fabsf(t[16 * k16 + k2] * gain[k0 + k64 + 16 * k16 + k2]));
                asm volatile("" ::: "memory"); } } }
#pragma unroll
    for (int o2 = 1; o2 < 64; o2 <<= 1) mx = fmaxf(mx, __shfl_xor(mx, o2));
    return mx;
}
template <int KIND>
__device__ __forceinline__ void i8_tile(Ctx& C, int t, unsigned char* wsl, LAS float* scr, int lane) {
    constexpr int Nsrc = KIND == 0 ? INW : DFF, mode = KIND == 0 ? 1 : 2;
    const int l = KIND == 0 ? t / (INP / 256) : 0, pn = KIND == 0 ? t % (INP / 256) : t;
    const float* s0 = KIND == 0 ? KIN(3) + (size_t)l * DM * INW : KIN(9); const float* s1 = KIND == 0 ? nullptr : KIN(10); const float* gain = KIND == 0 ? KIN(2) + l * DM : KIN(8);
    unsigned char* dst = KIND == 0 ? (unsigned char*)(wsl + WS_W_IN) + (size_t)l * INP * DM : (unsigned char*)(wsl + WS_W_FUP);
    float* sb = KIND == 0 ? (float*)(wsl + WS_SMALL + SM_SBIN) + l * (INP / 256) + pn : (float*)(wsl + WS_SMALL + SM_SBF) + pn;
    LAS float* red = (LAS float*)(C.lds + 8 * 16896);
    float mx = 0.f;
#pragma unroll 1
    for (int cg = 0; cg < 4; ++cg) mx = fmaxf(mx, wmax_item(s0, s1, Nsrc, gain, mode, pn * 256 + cg * 64, C.wave * 256, lane));
    if (lane == 0) red[C.wave] = mx;
    __syncthreads();
    float tm = 0.f;
#pragma unroll
    for (int w = 0; w < 8; ++w) tm = fmaxf(tm, red[w]);
    const float qs = tm > 0.f ? 127.0f / tm : 0.f;
    if (C.wave == 0 && lane == 0) *sb = tm * (1.0f / 127.0f);
#pragma unroll 1
    for (int it = C.wave; it < 4 * (DM / 64); it += 8) { const int cg = it & 3, kb = it >> 2;
        conv_item<2>(s0, s1, Nsrc, gain, dst, DM, mode, pn * 256 + cg * 64, kb * 64, scr, lane, qs); }
    __syncthreads();
}
__device__ __forceinline__ void phase_prepA(Ctx& C) {
    const int tidl = tid_l(), lane = tidl & 63; (void)lane;
    unsigned char* const wsl = launder(C.ws); unsigned* const ctll = (unsigned*)(wsl + WS_CTL);
    LAS float* scr = (LAS float*)(C.lds + C.wave * 16896);
    constexpr int I_OUT = (DM / 64) * (DM / 64), I_FDN = (DM / 64) * (DFF / 64), I_MUP = (2 * DFE / 64) * (DM / 64), I_MDN = (DM / 64) * (DFE / 64);
    constexpr int NTILE8 = 2 * (INP / 256) + 2 * DFF / 256;
    for (int t = C.bx; t < NTILE8; t += C.G) { if (t < 2 * (INP / 256)) i8_tile<0>(C, t, wsl, scr, lane); else i8_tile<1>(C, t - 2 * (INP / 256), wsl, scr, lane); }
    for (int r = C.gw; r < 2 * I_OUT; r += C.NGW) { const int l = r / I_OUT;
        conv_job(lane, r - l * I_OUT, KIN(7) + (size_t)l * DM * DM, nullptr, DM, nullptr, (bf16_t*)(wsl + WS_W_OUT) + (size_t)l * DM * DM, DM, DM, 0, scr); }
    for (int r = C.gw; r < I_FDN; r += C.NGW) conv_job(lane, r, KIN(11), nullptr, DM, nullptr, (bf16_t*)(wsl + WS_W_FDN), DFF, DM, 0, scr);
    for (;;) { int itb = 0; if (lane == 0) itb = (int)atomicAdd(ctll + CW_QUEUE, 8u); itb = __builtin_amdgcn_readfirstlane(itb);
        if (itb >= NE * I_MUP + NE * I_MDN) break;
#pragma unroll 1
      for (int it = itb; it < itb + 8 && it < NE * I_MUP + NE * I_MDN; ++it) {
        if (it < NE * I_MUP) { const int e = it / I_MUP;
            conv_job<1>(lane, it - e * I_MUP, KIN(13) + (size_t)e * DM * DFE, KIN(14) + (size_t)e * DM * DFE, DFE, KIN(8) + DM, (unsigned char*)(wsl + WS_W_MUP) + (size_t)e * 2 * DFE * DM, DM, 2 * DFE, 2, scr, S_WUP8); }
        else { const int r = it - NE * I_MUP, e = r / I_MDN;
            conv_job<1>(lane, r - e * I_MDN, KIN(15) + (size_t)e * DFE * DM, nullptr, DM, nullptr, (unsigned char*)(wsl + WS_W_MDN) + (size_t)e * DM * DFE, DFE, DM, 0, scr, S_WDN8); } } }
    float* rc = (float*)(wsl + WS_ROPE); float* rsn = rc + SEQ * 128;
    for (int i = C.gw * 64 + lane; i < SEQ * 128; i += C.NGW * 64) { const int pos = i >> 7, j = i & 127;
        const float inv = (float)pow(10000.0, -(double)j / 128.0); const float ang = (float)pos * inv; double sn, cs; sincos((double)ang, &sn, &cs); rc[i] = (float)cs; rsn[i] = (float)sn; }
    int* list = (int*)(wsl + WS_SMALL + SM_LIST);
    float* rfac = (float*)(wsl + WS_SMALL + SM_RFAC);
    for (int i = C.gw * 64 + lane; i < NE * NTOK; i += C.NGW * 64) { list[i] = 0; rfac[i] = 0.f; }
}

template <bool ROUTER>
__device__ __forceinline__ void phase_stats(Ctx& C, const float* h, int layer) {
    const int tidl = tid_l(), lane = tidl & 63; (void)lane;
    unsigned char* const wsl = launder(C.ws); unsigned* const ctll = (unsigned*)(wsl + WS_CTL); (void)ctll;
    bf16_t* hb = (bf16_t*)(wsl + WS_HB); float* rstd = (float*)(wsl + WS_SMALL + SM_RSTD);
    const float* gain = KIN(8) + layer * DM; const float* wr = KIN(12);
    for (int row = C.gw; row < NTOK; row += C.NGW) {
        const f32x4* p = (const f32x4*)(h + (size_t)row * DM) + lane; f32x4 v[8]; float ss = 0.f;
#pragma unroll
        for (int j = 0; j < 8; ++j) { v[j] = p[64 * j]; ss += (v[j][0] * v[j][0] + v[j][1] * v[j][1]) + (v[j][2] * v[j][2] + v[j][3] * v[j][3]); }
        ss = wave_sum(ss); const float r = 1.0f / sqrtf(ss * (1.0f / DM) + EPS);
        if (lane == 0) rstd[row] = r;
        if constexpr (!ROUTER) {
            float mx = 0.f;
#pragma unroll
            for (int j = 0; j < 8; ++j) mx = fmaxf(fmaxf(mx, fmaxf(fabsf(v[j][0]), fabsf(v[j][1]))), fmaxf(fabsf(v[j][2]), fabsf(v[j][3])));
#pragma unroll
            for (int o2 = 1; o2 < 64; o2 <<= 1) mx = fmaxf(mx, __shfl_xor(mx, o2));
            const float q = mx > 0.f ? 127.0f / mx : 0.f;
            if (lane == 0) ((float*)(wsl + WS_SMALL + SM_SA))[row] = mx * (1.0f / 127.0f);
            unsigned* o8 = (unsigned*)(wsl + WS_HB8 + (size_t)row * DM) + lane;
#pragma unroll
            for (int j = 0; j < 8; ++j) o8[64 * j] = pk4_i8(v[j][0] * q, v[j][1] * q, v[j][2] * q, v[j][3] * q);
        } else {
            unsigned* o8 = (unsigned*)(wsl + WS_HB8 + (size_t)row * DM) + lane;
#pragma unroll
            for (int j = 0; j < 8; ++j) o8[64 * j] = cvt_pk4_fp8(v[j][0] * S_HB8, v[j][1] * S_HB8, v[j][2] * S_HB8, v[j][3] * S_HB8);
        }
        if constexpr (ROUTER) {
            float lg[NE];
#pragma unroll
            for (int e = 0; e < NE; ++e) lg[e] = 0.f;
#pragma unroll
            for (int j = 0; j < 8; ++j) { const int k0 = 4 * lane + 256 * j; const f32x4 g4 = *(const f32x4*)(gain + k0);
#pragma unroll
                for (int q = 0; q < 4; ++q) { const float x = v[j][q] * g4[q]; const f32x4 w0 = *(const f32x4*)(wr + (size_t)(k0 + q) * NE), w1 = *(const f32x4*)(wr + (size_t)(k0 + q) * NE + 4);
                    lg[0] += x * w0[0]; lg[1] += x * w0[1]; lg[2] += x * w0[2]; lg[3] += x * w0[3]; lg[4] += x * w1[0]; lg[5] += x * w1[1]; lg[6] += x * w1[2]; lg[7] += x * w1[3]; } }
#pragma unroll
            for (int e = 0; e < NE; ++e) lg[e] = wave_sum(lg[e]) * r;
            int i1 = 0; float v1 = lg[0];
#pragma unroll
            for (int e = 1; e < NE; ++e) if (lg[e] > v1) { v1 = lg[e]; i1 = e; }
            int i2 = -1; float v2 = -3.0e38f;
#pragma unroll
            for (int e = 0; e < NE; ++e) if (e != i1 && lg[e] > v2) { v2 = lg[e]; i2 = e; }
            const float g1 = 1.0f / (1.0f + __expf(v2 - v1)), g2 = 1.0f - g1;
            if (lane == 0) {
                const int s1 = (int)atomicAdd(ctll + CW_CNT + 64 * i1, 1u), s2 = (int)atomicAdd(ctll + CW_CNT + 64 * i2, 1u);
                int* list = (int*)(wsl + WS_SMALL + SM_LIST); list[i1 * NTOK + s1] = row; list[i2 * NTOK + s2] = row;
                float* rfac = (float*)(wsl + WS_SMALL + SM_RFAC); rfac[i1 * NTOK + s1] = r; rfac[i2 * NTOK + s2] = r;
                int* te = (int*)(wsl + WS_SMALL + SM_TOKE); int* ts = (int*)(wsl + WS_SMALL + SM_TOKS); float* tg = (float*)(wsl + WS_SMALL + SM_TOKG);
                te[2 * row] = i1; te[2 * row + 1] = i2; ts[2 * row] = s1; ts[2 * row + 1] = s2; tg[2 * row] = g1; tg[2 * row + 1] = g2;
            }
        }
    }
}

__device__ __forceinline__ void phase_rstd(Ctx& C) {
    const int tidl = tid_l(), lane = tidl & 63;
    unsigned char* const wsl = launder(C.ws);
    const bf16_t* hb = (const bf16_t*)(wsl + WS_HB); float* rstd = (float*)(wsl + WS_SMALL + SM_RSTD); float* sa = (float*)(wsl + WS_SMALL + SM_SA);
    for (int row = C.gw; row < NTOK; row += C.NGW) {
        const u32x4* p = (const u32x4*)(hb + (size_t)row * DM) + lane; float ss = 0.f, mx = 0.f; u32x4 w[4];
#pragma unroll
        for (int j = 0; j < 4; ++j) { w[j] = p[64 * j];
#pragma unroll
            for (int q = 0; q < 4; ++q) { const float a = bf_lo(w[j][q]), b = bf_hi(w[j][q]); ss += a * a + b * b; mx = fmaxf(mx, fmaxf(fabsf(a), fabsf(b))); } }
        ss = wave_sum(ss);
#pragma unroll
        for (int o2 = 1; o2 < 64; o2 <<= 1) mx = fmaxf(mx, __shfl_xor(mx, o2));
        const float qq = mx > 0.f ? 127.0f / mx : 0.f;
        if (lane == 0) { rstd[row] = 1.0f / sqrtf(ss * (1.0f / DM) + EPS); sa[row] = mx * (1.0f / 127.0f); }
        u32x2* o8 = (u32x2*)(wsl + WS_HB8 + (size_t)row * DM) + lane;
#pragma unroll
        for (int j = 0; j < 4; ++j) { u32x2 o; o.x = pk4_i8(bf_lo(w[j][0]) * qq, bf_hi(w[j][0]) * qq, bf_lo(w[j][1]) * qq, bf_hi(w[j][1]) * qq);
            o.y = pk4_i8(bf_lo(w[j][2]) * qq, bf_hi(w[j][2]) * qq, bf_lo(w[j][3]) * qq, bf_hi(w[j][3]) * qq); o8[64 * j] = o; }
    }
}

__device__ __forceinline__ void phase_post(Ctx& C, int layer) {
    const int tidl = tid_l(), lane = tidl & 63; (void)lane;
    unsigned char* const wsl = launder(C.ws); unsigned* const ctll = (unsigned*)(wsl + WS_CTL); (void)ctll;
    bf16_t* q = (bf16_t*)(wsl + WS_PROJ + PJ_Q); bf16_t* k = (bf16_t*)(wsl + WS_PROJ + PJ_K);
    const float* qg = KIN(4) + layer * AD; const float* kg = KIN(5) + layer * AD;
    const float qsc = 0.088388347648318440f * LOG2E;
    const f32x2 qg2 = *(const f32x2*)(qg + 2 * lane), kg2 = *(const f32x2*)(kg + 2 * lane);
    for (int row = C.gw; row < NTOK; row += C.NGW) {
        unsigned* qr = (unsigned*)(q + (size_t)row * 1024) + lane; unsigned* kr = (unsigned*)(k + (size_t)row * 256) + lane;
        unsigned w[10];
#pragma unroll
        for (int hh = 0; hh < 8; ++hh) w[hh] = qr[64 * hh];
        w[8] = kr[0]; w[9] = kr[64];
#pragma unroll
        for (int hh = 0; hh < 10; ++hh) { const float a = bf_lo(w[hh]), b = bf_hi(w[hh]); const float ss = wave_sum(a * a + b * b); const float r = 1.0f / sqrtf(ss * (1.0f / AD) + EPS);
            if (hh < 8) qr[64 * hh] = cvt_pk_bf16(a * r * qg2[0] * qsc, b * r * qg2[1] * qsc); else kr[64 * (hh - 8)] = cvt_pk_bf16(a * r * kg2[0], b * r * kg2[1]); }
    }
}

__device__ __forceinline__ void phase_retscan(Ctx& C) {
    const int tidl = tid_l(), lane = tidl & 63;
    unsigned char* const wsl = launder(C.ws);
    const float* KVT = (const float*)(wsl + WS_PROJ + PJ_KVT); bf16_t* SV = (bf16_t*)(wsl + WS_PROJ + PJ_SV);
    for (int idx = C.gw * 64 + lane; idx < 16 * 256 * 64; idx += C.NGW * 64) {
        const int bh = idx >> 14, e = (idx >> 6) & 255, d4 = idx & 63, b = bh >> 2, h = bh & 3;
        const float g256 = __builtin_amdgcn_exp2f(256.0f * __builtin_log2f(1.0f - __builtin_exp2f(-5.0f - (float)h)));
        f32x4 S = {0.f, 0.f, 0.f, 0.f};
#pragma unroll 4
        for (int n = 0; n < 16; ++n) { const size_t tile = (size_t)(b * 16 + n) * 4 + h;
            u32x2 w; w.x = cvt_pk_bf16(S[0], S[1]); w.y = cvt_pk_bf16(S[2], S[3]);
            *(u32x2*)(SV + (tile * 256 + e) * 512 + 4 * d4) = w;
            if (n < 15) { const f32x4 kv = *(const f32x4*)(KVT + tile * 65536 + (size_t)e * 256 + 4 * d4); S = S * g256 + kv; } }
    }
}

__device__ __forceinline__ void phase_combine(Ctx& C) {
    const int tidl = tid_l(), lane = tidl & 63; (void)lane;
    unsigned char* const wsl = launder(C.ws); unsigned* const ctll = (unsigned*)(wsl + WS_CTL); (void)ctll;
    const MoeInfo mi = moe_info(ctll);
    const bf16_t* Y = (const bf16_t*)(wsl + WS_PROJ + PJ_Y);
    const int* te = (const int*)(wsl + WS_SMALL + SM_TOKE); const int* ts = (const int*)(wsl + WS_SMALL + SM_TOKS); const float* tg = (const float*)(wsl + WS_SMALL + SM_TOKG);
    for (int row = C.gw; row < NTOK; row += C.NGW) {
        const int e1 = te[2 * row], e2 = te[2 * row + 1]; const float g1 = tg[2 * row], g2 = tg[2 * row + 1];
        int t1 = 0, t2 = 0;
#pragma unroll
        for (int e = 0; e < NE; ++e) { t1 = (e == e1) ? mi.toff[e] : t1; t2 = (e == e2) ? mi.toff[e] : t2; }
        const size_t p1 = (size_t)t1 * 256 + ts[2 * row], p2 = (size_t)t2 * 256 + ts[2 * row + 1];
#pragma unroll
        for (int j = 0; j < 4; ++j) { const int c = 8 * lane + 512 * j;
            const u32x4 a = *(const u32x4*)(Y + p1 * DM + c), b = *(const u32x4*)(Y + p2 * DM + c);
            float* op = KOUT + (size_t)row * DM + c; f32x4 o0 = *(const f32x4*)op, o1 = *(const f32x4*)(op + 4);
            o0[0] += g1 * bf_lo(a.x) + g2 * bf_lo(b.x); o0[1] += g1 * bf_hi(a.x) + g2 * bf_hi(b.x); o0[2] += g1 * bf_lo(a.y) + g2 * bf_lo(b.y); o0[3] += g1 * bf_hi(a.y) + g2 * bf_hi(b.y);
            o1[0] += g1 * bf_lo(a.z) + g2 * bf_lo(b.z); o1[1] += g1 * bf_hi(a.z) + g2 * bf_hi(b.z); o1[2] += g1 * bf_lo(a.w) + g2 * bf_lo(b.w); o1[3] += g1 * bf_hi(a.w) + g2 * bf_hi(b.w);
            *(f32x4*)op = o0; *(f32x4*)(op + 4) = o1; }
    }
}

__device__ __forceinline__ void phase_scores(Ctx& C) {
    const int tidl = tid_l(), lane = tidl & 63; (void)lane;
    unsigned char* const wsl = launder(C.ws); unsigned* const ctll = (unsigned*)(wsl + WS_CTL); (void)ctll;
    const bf16_t* iq = (const bf16_t*)(wsl + WS_PROJ + PJ_IQ); const bf16_t* ik = (const bf16_t*)(wsl + WS_PROJ + PJ_IK);
    const float* iw = (const float*)(wsl + WS_PROJ + PJ_IW); float* sc = (float*)(wsl + WS_BIG);
    const int r = lane & 31, hi = lane >> 5;
    for (int U = C.bx; U < NBATCH * 288; U += C.G) {
        int b, n, g;
        { const int rnd = U / C.G, cc = U - rnd * C.G; const int k = (C.G == 256) ? rnd * 256 + ((rnd & 1) ? 255 - cc : cc) : U;
          if (k < 928) { b = k & 3; const int kk = k >> 2; int j = 1; while (4 * (j + 1) * j <= kk) ++j; const int r_ = kk - 4 * j * (j - 1); n = 8 * j + r_ / j - 1; g = r_ % j; }
          else { const int idx = k - 928, sz = 7 - (idx >> 5), t = (idx >> 2) & 7; b = idx & 3; n = 8 * t + sz - 1; g = t; } }
        const int t0 = b * SEQ + 64 * n + 8 * C.wave;
        bf16x8 Af[4][4]; f32x4 wv[4][4];
#pragma unroll
        for (int blk = 0; blk < 4; ++blk) { const int qi = 2 * blk + ((r >> 2) & 1), head = 4 * (r >> 3) + (r & 3);
            const bf16_t* p = iq + (size_t)(t0 + qi) * 1024 + head * 64 + 8 * hi;
#pragma unroll
            for (int ks = 0; ks < 4; ++ks) Af[blk][ks] = *(const bf16x8*)(p + 16 * ks);
            const float* wp = iw + (size_t)(t0 + 2 * blk + hi) * 16;
#pragma unroll
            for (int i = 0; i < 4; ++i) wv[blk][i] = *(const f32x4*)(wp + 4 * i); }
        const int kt1 = (8 * g + 8 < n + 1) ? 8 * g + 8 : n + 1, ntile = kt1 - 8 * g;
        __syncthreads();
        { const unsigned char* src = (const unsigned char*)(ik + (size_t)(b * SEQ + 512 * g) * 64);
          for (int off = tidl * 16; off < ntile * 8192; off += 512 * 16) { const int row = off >> 7, ch = (off >> 4) & 7;
              *(LAS u32x4*)(C.lds + row * 128 + ((ch ^ ((row >> 1) & 7)) << 4)) = *(const u32x4*)(src + off); } }
        __syncthreads();
#define SC_TILE(kt) do { bf16x8 Bf[2][4]; \
            _Pragma("unroll") for (int kb = 0; kb < 2; ++kb) { const int row_ = 64 * ((kt) - 8 * g) + 32 * kb + r; \
                _Pragma("unroll") for (int ks = 0; ks < 4; ++ks) Bf[kb][ks] = *(const LAS bf16x8*)(C.lds + row_ * 128 + (((2 * ks + hi) ^ ((row_ >> 1) & 7)) << 4)); } \
            _Pragma("unroll") for (int blk = 0; blk < 4; ++blk) { f32x16 a0 = {}, a1 = {}; \
            _Pragma("unroll") for (int ks = 0; ks < 4; ++ks) { a0 = __builtin_amdgcn_mfma_f32_32x32x16_bf16(Af[blk][ks], Bf[0][ks], a0, 0, 0, 0); a1 = __builtin_amdgcn_mfma_f32_32x32x16_bf16(Af[blk][ks], Bf[1][ks], a1, 0, 0, 0); } \
            float s0 = 0.f, s1 = 0.f; \
            _Pragma("unroll") for (int i = 0; i < 16; ++i) { s0 += wv[blk][i >> 2][i & 3] * fmaxf(a0[i], 0.f); s1 += wv[blk][i >> 2][i & 3] * fmaxf(a1[i], 0.f); } \
            float* o_ = sc + (size_t)(t0 + 2 * blk + hi) * SEQ + 64 * (kt) + r; o_[0] = s0; o_[32] = s1; } } while (0)
        for (int kt = 8 * g; kt < kt1; ++kt) SC_TILE(kt);
#undef SC_TILE
    }
}

__device__ __forceinline__ void phase_select(Ctx& C) {
    const int tidl = tid_l(), lane = tidl & 63;
    unsigned char* const wsl = launder(C.ws);
    const float* sc = (const float*)(wsl + WS_BIG); unsigned long long* mask = (unsigned long long*)(wsl + WS_MASK);
    LAS unsigned* hist = (LAS unsigned*)(C.lds + C.wave * 16384);
    for (int row = C.gw; row < NTOK; row += C.NGW) {
        const int n = (row & (SEQ - 1)) >> 6;
        unsigned wlo, whi;
        if (n < 4) { wlo = (lane <= n) ? 0xffffffffu : 0u; whi = wlo; }
        else {
            const bool act = lane <= n;
            float key[64];
            { const f32x4* sr = (const f32x4*)(sc + (size_t)row * SEQ + 64 * lane);
#pragma unroll
              for (int i = 0; i < 16; ++i) { f32x4 v = {0.f, 0.f, 0.f, 0.f}; if (act) v = sr[i]; key[4 * i] = v[0]; key[4 * i + 1] = v[1]; key[4 * i + 2] = v[2]; key[4 * i + 3] = v[3]; } }
            float mn = 3.0e38f, mx = -3.0e38f;
#pragma unroll
            for (int j = 0; j < 64; ++j) { mn = fminf(mn, key[j]); mx = fmaxf(mx, key[j]); }
            if (!act) { mn = 3.0e38f; mx = -3.0e38f; }
#pragma unroll
            for (int o = 1; o < 64; o <<= 1) { mn = fminf(mn, __shfl_xor(mn, o)); mx = fmaxf(mx, __shfl_xor(mx, o)); }
            const float rng = mx - mn, scale = rng > 0.f ? 4095.5f / rng : 0.f;
            { const u32x4 z = {0u, 0u, 0u, 0u};
#pragma unroll
              for (int i = 0; i < 16; ++i) *(LAS u32x4*)(hist + 4 * (lane + 64 * i)) = z; }
            LDS_WAIT();
            int bin[64];
#pragma unroll
            for (int j = 0; j < 64; ++j) { int bq = (int)((key[j] - mn) * scale); bq = bq > 4095 ? 4095 : bq; bin[j] = bq; }
            if (act) {
#pragma unroll
                for (int j = 0; j < 64; ++j) __hip_atomic_fetch_add(hist + bin[j], 1u, __ATOMIC_RELAXED, __HIP_MEMORY_SCOPE_WORKGROUP);
            }
            LDS_WAIT(); asm volatile("" ::: "memory");
            unsigned h[64]; unsigned cl = 0u;
#pragma unroll
            for (int i = 0; i < 16; ++i) { const u32x4 v = *(const LAS u32x4*)(hist + 64 * lane + 4 * i); h[4 * i] = v[0]; h[4 * i + 1] = v[1]; h[4 * i + 2] = v[2]; h[4 * i + 3] = v[3]; cl += (v[0] + v[1]) + (v[2] + v[3]); }
            unsigned suf = cl;
#pragma unroll
            for (int o = 1; o < 64; o <<= 1) { const unsigned t = __shfl_down(suf, o); if (lane + o < 64) suf += t; }
            const unsigned above = suf - cl;
            unsigned run = above; int bsel = -1; unsigned cab = 0u;
#pragma unroll
            for (int i = 63; i >= 0; --i) { const unsigned prev = run; run += h[i]; if (run >= 256u && prev < 256u) { bsel = i; cab = prev; } }
            const unsigned long long ff = __ballot(bsel >= 0);
            const int Ls = __builtin_ctzll(ff);
            const int B = __shfl(64 * lane + bsel, Ls); const int chi = (int)__shfl(cab, Ls);
            int need = 256 - chi;
            unsigned hlo = 0u, hhi = 0u, clo = 0u, chh = 0u;
#pragma unroll
            for (int j = 0; j < 32; ++j) { hlo |= (bin[j] > B) ? (1u << j) : 0u; clo |= (bin[j] == B) ? (1u << j) : 0u; hhi |= (bin[32 + j] > B) ? (1u << j) : 0u; chh |= (bin[32 + j] == B) ? (1u << j) : 0u; }
            if (!act) { hlo = 0u; hhi = 0u; clo = 0u; chh = 0u; }
            int m = __builtin_popcount(clo) + __builtin_popcount(chh);
#pragma unroll
            for (int o = 1; o < 64; o <<= 1) m += __shfl_xor(m, o);
            unsigned slo = clo, shi = chh;
            if (m != need) {
                slo = 0u; shi = 0u;
                for (int it = 0; it < need; ++it) {
                    float bk = -3.0e38f; int bj = 64;
#pragma unroll
                    for (int j = 0; j < 64; ++j) { const unsigned cb = j < 32 ? (clo & ~slo) : (chh & ~shi); const bool c = ((cb >> (j & 31)) & 1u) && (key[j] > bk); bk = c ? key[j] : bk; bj = c ? j : bj; }
                    float wm = bk;
#pragma unroll
                    for (int o = 1; o < 64; o <<= 1) wm = fmaxf(wm, __shfl_xor(wm, o));
                    const unsigned long long wf = __ballot(bj < 64 && bk == wm);
                    const int wl = __builtin_ctzll(wf);
                    if (lane == wl) { if (bj < 32) slo |= 1u << bj; else shi |= 1u << (bj - 32); }
                }
            }
            wlo = hlo | slo; whi = hhi | shi;
        }
        mask[(size_t)row * 64 + lane] = ((unsigned long long)whi << 32) | wlo;
    }
}

namespace at {
constexpr int D = 128, KVBLK = 64;
constexpr int SHM_V = KVBLK * D * 2, SHM_K = KVBLK * D * 2;
constexpr int NBUF = 3;
constexpr int OFF_WS = NBUF * SHM_V + NBUF * SHM_K, OFF_BIAS = OFF_WS + 8 * 64 * 4, LDS_BYTES = OFF_BIAS + 4 * 160 * 4;
constexpr float THR2 = 11.5f;
#define KSWZ(row, colB) ((row) * 256 + ((colB) ^ (((row) & 7) << 4)))
#define SBAR() __builtin_amdgcn_sched_barrier(0)
__device__ __forceinline__ int crow(int r, int hi) { return (r & 3) + 8 * (r >> 2) + 4 * hi; }
__device__ __forceinline__ void partialSM(f32x16& p0, f32x16& p1, float& m_reg, float& mn, float& alpha) {
    float pmax = p0[0];
#pragma unroll
    for (int r = 1; r < 16; ++r) pmax = fmaxf(pmax, p0[r]);
#pragma unroll
    for (int r = 0; r < 16; ++r) pmax = fmaxf(pmax, p1[r]);
    { auto rr = __builtin_amdgcn_permlane32_swap(__float_as_uint(pmax), __float_as_uint(pmax), false, false);
      pmax = fmaxf(__uint_as_float(rr[0]), __uint_as_float(rr[1])); }
    { const bool keep = __all(pmax - m_reg <= THR2);
      const float mcand = fmaxf(m_reg, pmax); mn = keep ? m_reg : mcand; alpha = keep ? 1.f : __builtin_amdgcn_exp2f(m_reg - mcand); m_reg = mn; }
#pragma unroll
    for (int r = 0; r < 16; ++r) p0[r] = p0[r] - mn;
#pragma unroll
    for (int r = 0; r < 16; ++r) p1[r] = p1[r] - mn;
#pragma unroll
    for (int r = 0; r < 16; ++r) p0[r] = __builtin_amdgcn_exp2f(p0[r]);
}
__device__ __forceinline__ void finishSM(f32x16& p0, f32x16& p1, float alpha, float& l_reg, bf16x8& pa0, bf16x8& pa1, bf16x8& pa2, bf16x8& pa3) {
#pragma unroll
    for (int r = 0; r < 16; ++r) p1[r] = __builtin_amdgcn_exp2f(p1[r]);
    float ps = 0;
#pragma unroll
    for (int r = 0; r < 16; ++r) ps += p0[r];
#pragma unroll
    for (int r = 0; r < 16; ++r) ps += p1[r];
    { auto rr = __builtin_amdgcn_permlane32_swap(__float_as_uint(ps), __float_as_uint(ps), false, false);
      ps = __uint_as_float(rr[0]) + __uint_as_float(rr[1]); }
    l_reg = l_reg * alpha + ps;
#define PK4(P, BASE, OUT) do { unsigned a0 = cvt_pk_bf16(P[BASE + 0], P[BASE + 1]), a1 = cvt_pk_bf16(P[BASE + 2], P[BASE + 3]);   \
    unsigned b0 = cvt_pk_bf16(P[BASE + 4], P[BASE + 5]), b1 = cvt_pk_bf16(P[BASE + 6], P[BASE + 7]);                              \
    auto r0 = __builtin_amdgcn_permlane32_swap(a0, b0, false, false); auto r1 = __builtin_amdgcn_permlane32_swap(a1, b1, false, false); \
    u32x4 w = {r0[0], r1[0], r0[1], r1[1]}; OUT = *reinterpret_cast<bf16x8*>(&w); } while (0)
    PK4(p0, 0, pa0); PK4(p0, 8, pa1); PK4(p1, 0, pa2); PK4(p1, 8, pa3);
#undef PK4
}
__device__ __forceinline__ void qkt(f32x16& p0, f32x16& p1, const LAS char* Ks, const bf16x8* qr, int r32, int hi) {
    p0 = f32x16{}; p1 = f32x16{};
#pragma unroll
    for (int d0 = 0; d0 < 8; ++d0) { const int cb = (d0 * 16 + hi * 8) * 2;
        const bf16x8 b0 = *(const LAS bf16x8*)(Ks + KSWZ(r32, cb));
        const bf16x8 b1 = *(const LAS bf16x8*)(Ks + KSWZ(32 + r32, cb));
        p0 = __builtin_amdgcn_mfma_f32_32x32x16_bf16(b0, qr[d0], p0, 0, 0, 0);
        p1 = __builtin_amdgcn_mfma_f32_32x32x16_bf16(b1, qr[d0], p1, 0, 0, 0); }
}
__device__ __forceinline__ int v_st(int k, int c) { const int kk = (k & ~0xC) | ((k & 4) << 1) | ((k & 8) >> 1); return ((kk >> 3) * 4 + (c >> 5)) * 512 + ((kk & 7) * 32 + (c & 31)) * 2; }
__device__ __forceinline__ int v_rd_base(int lane) { return ((lane & 3) << 3) | (((lane >> 2) & 3) << 6) | (((lane >> 4) & 1) << 5) | (((lane >> 5) & 1) << 8); }
constexpr int v_rd_off(int d0, int ks, int half) { return d0 * 512 + ks * 4096 + half * 2048; }
template <int OFF> __device__ __forceinline__ s16x4 tr_read(const LAS char* vb) { return __builtin_amdgcn_ds_read_tr16_b64_v4i16((LAS s16x4*)(vb + OFF)); }
template <int KS> __device__ __forceinline__ void pv_step(f32x16* o, const LAS char* vb, bf16x8 pa) {
#define PK(L, H) (bf16x8){L[0], L[1], L[2], L[3], H[0], H[1], H[2], H[3]}
    { const s16x4 l = tr_read<v_rd_off(0, KS, 0)>(vb), h = tr_read<v_rd_off(0, KS, 1)>(vb); o[0] = __builtin_amdgcn_mfma_f32_32x32x16_bf16(pa, PK(l, h), o[0], 0, 0, 0); }
    { const s16x4 l = tr_read<v_rd_off(1, KS, 0)>(vb), h = tr_read<v_rd_off(1, KS, 1)>(vb); o[1] = __builtin_amdgcn_mfma_f32_32x32x16_bf16(pa, PK(l, h), o[1], 0, 0, 0); }
    { const s16x4 l = tr_read<v_rd_off(2, KS, 0)>(vb), h = tr_read<v_rd_off(2, KS, 1)>(vb); o[2] = __builtin_amdgcn_mfma_f32_32x32x16_bf16(pa, PK(l, h), o[2], 0, 0, 0); }
    { const s16x4 l = tr_read<v_rd_off(3, KS, 0)>(vb), h = tr_read<v_rd_off(3, KS, 1)>(vb); o[3] = __builtin_amdgcn_mfma_f32_32x32x16_bf16(pa, PK(l, h), o[3], 0, 0, 0); }
#undef PK
}
__device__ __forceinline__ void pv_d0(f32x16* o, const LAS char* vb, bf16x8 pa0, bf16x8 pa1, bf16x8 pa2, bf16x8 pa3) {
    pv_step<0>(o, vb, pa0); pv_step<1>(o, vb, pa1); pv_step<2>(o, vb, pa2); pv_step<3>(o, vb, pa3);
}
__device__ __forceinline__ void bias_tile(f32x16& p0, f32x16& p1, int hi, const LAS float* bt, int relbase) {
#pragma unroll
    for (int r = 0; r < 16; ++r) { const int kc = (r & 3) + 8 * (r >> 2); int i0 = relbase + kc + 4 * hi; i0 = i0 < 0 ? 0 : i0; int i1 = relbase + 32 + kc + 4 * hi; i1 = i1 < 0 ? 0 : i1;
        p0[r] += bt[i0]; p1[r] += bt[i1]; }
}
__device__ __forceinline__ void mask_tile(f32x16& p0, f32x16& p1, unsigned long long mw, int hi) {
    const float ninf = -__builtin_inff();
    const unsigned lo = (unsigned)mw >> (4 * hi), hw = (unsigned)(mw >> 32) >> (4 * hi);
#pragma unroll
    for (int r = 0; r < 16; ++r) { const unsigned bit = 1u << ((r & 3) + 8 * (r >> 2)); p0[r] = (lo & bit) ? p0[r] : ninf; p1[r] = (hw & bit) ? p1[r] : ninf; }
}
__device__ __forceinline__ int t5_bucket(int rel) {
    const int n = rel < 0 ? -rel : rel; int bk;
    if (n < 8) bk = n; else if (n < 12) bk = 8; else if (n < 16) bk = 9; else if (n < 23) bk = 10; else if (n < 32) bk = 11; else if (n < 46) bk = 12; else if (n < 64) bk = 13; else if (n < 91) bk = 14; else bk = 15;
    return bk + (rel > 0 ? 16 : 0);
}

template <int PVAR> __device__ __forceinline__ void attn_unit(const bf16_t* __restrict__ Q, const bf16_t* __restrict__ K, const bf16_t* __restrict__ V, const unsigned long long* __restrict__ mask,
                                          const float* __restrict__ rel_bias, bf16_t* __restrict__ mix, int b, int kvh, int n, LAS char* lds) {
#define PV_ON(bit) (!(PVAR & (bit)))
    const int tid = tid_l(), wid = tid >> 6, lane = tid & 63, r32 = lane & 31, hi = lane >> 5;
    const int hl = wid >> 1, qsub = wid & 1, hq = kvh * 4 + hl, tq = 64 * n + 32 * qsub + r32;
    LAS char* V_lds = lds; LAS char* K_lds = lds + NBUF * SHM_V;
    LAS float* wsw = (LAS float*)(lds + OFF_WS) + wid * 64; LAS float* li_l = wsw; LAS float* al_l = wsw + 32;
    LAS float* btab = (LAS float*)(lds + OFF_BIAS);
    for (int i = tid; i < 4 * 160; i += 512) { const int h4 = i / 160, idx = i % 160; const int rel = idx - 91; float v = 0.f;
        if (idx < 155) v = (rel_bias[t5_bucket(rel) * AH + kvh * 4 + h4] - rel_bias[15 * AH + kvh * 4 + h4]) * LOG2E;
        btab[i] = v; }
    float m_reg = -1e30f, l_reg = 0; f32x16 o[4] = {}; bf16x8 qr[8];
    const bf16_t* Qw = Q + (size_t)(b * SEQ + tq) * 1024 + hq * 128 + hi * 8;
#pragma unroll
    for (int d0 = 0; d0 < 8; ++d0) qr[d0] = *(const bf16x8*)(Qw + d0 * 16);
    const bf16_t* Kh = K + (size_t)b * SEQ * 256 + kvh * 128; const bf16_t* Vh = V + (size_t)b * SEQ * 256 + kvh * 128;
    const unsigned long long* mrow = mask + (size_t)(b * SEQ + tq) * 64;
    const LAS float* bt = btab + hl * 160;
    const int sr = tid >> 4, sc = (tid & 15) * 8, vst0 = v_st(sr, sc), vst1 = v_st(32 + sr, sc);
    const LAS char* vb0 = V_lds + v_rd_base(lane);
    bf16x8 sv0, sv1, sk0, sk1;
#define SLOAD(k0) do { sv0 = *(const bf16x8*)(&Vh[(size_t)((k0) + sr) * 256 + sc]); sv1 = *(const bf16x8*)(&Vh[(size_t)((k0) + 32 + sr) * 256 + sc]); \
    sk0 = *(const bf16x8*)(&Kh[(size_t)((k0) + sr) * 256 + sc]); sk1 = *(const bf16x8*)(&Kh[(size_t)((k0) + 32 + sr) * 256 + sc]); } while (0)
#define SWRITE(bb) do { *(LAS bf16x8*)(V_lds + (bb) * SHM_V + vst0) = sv0; *(LAS bf16x8*)(V_lds + (bb) * SHM_V + vst1) = sv1; const int kc = sc * 2; \
    *(LAS bf16x8*)(K_lds + (bb) * SHM_K + KSWZ(sr, kc)) = sk0; *(LAS bf16x8*)(K_lds + (bb) * SHM_K + KSWZ(32 + sr, kc)) = sk1; } while (0)
#define RESC(a) do { if (__any((a) < 1.f)) { if (hi == 0) al_l[r32] = (a); asm volatile("s_waitcnt lgkmcnt(0)" ::: "memory"); \
    _Pragma("unroll") for (int d = 0; d < 4; ++d) _Pragma("unroll") for (int r = 0; r < 16; ++r) o[d][r] *= al_l[crow(r, hi)]; } } while (0)
    f32x16 pA0, pA1, pB0, pB1; float mnA, mnB, alA, alB; bf16x8 pa0, pa1, pa2, pa3;
    const int NT = (n + 2) & ~1;
#define BIAST(P0, P1, kt) do { if ((kt) + 2 >= n && (kt) <= n) bias_tile(P0, P1, hi, bt, 64 * ((kt) - n) - 32 * qsub - r32 + 91); } while (0)
#define SG_R1() do { _Pragma("unroll") for (int g_ = 0; g_ < 16; ++g_) { __builtin_amdgcn_sched_group_barrier(0x008, 1, 0); __builtin_amdgcn_sched_group_barrier(0x100, 1, 0); __builtin_amdgcn_sched_group_barrier(0x002, 5, 0); } } while (0)
#define SG_R2() do { _Pragma("unroll") for (int g_ = 0; g_ < 16; ++g_) { __builtin_amdgcn_sched_group_barrier(0x008, 1, 0); __builtin_amdgcn_sched_group_barrier(0x100, 2, 0); __builtin_amdgcn_sched_group_barrier(0x002, 12, 0); } } while (0)
    unsigned long long mwA = mrow[0], mwB = mrow[1];
    SLOAD(0); asm volatile("s_waitcnt vmcnt(0)" ::: "memory"); SWRITE(0); SLOAD(KVBLK); __syncthreads();
    qkt(pA0, pA1, K_lds, qr, r32, hi); BIAST(pA0, pA1, 0); mask_tile(pA0, pA1, mwA, hi); partialSM(pA0, pA1, m_reg, mnA, alA);
    SWRITE(1); if (2 < NT) SLOAD(2 * KVBLK); __syncthreads();
    int b0 = 0, b1 = 1, b2 = 2;
    for (int j = 1; j + 1 < NT; j += 2) {
        if constexpr (PVAR == 0) {
        SBAR(); qkt(pB0, pB1, K_lds + b1 * SHM_K, qr, r32, hi);
        finishSM(pA0, pA1, alA, l_reg, pa0, pa1, pa2, pa3); SG_R1(); SBAR();
        BIAST(pB0, pB1, j);
        SBAR(); pv_d0(o, vb0 + b0 * SHM_V, pa0, pa1, pa2, pa3); mask_tile(pB0, pB1, mwB, hi); partialSM(pB0, pB1, m_reg, mnB, alB); SG_R2(); SBAR();
        RESC(alB);
        SWRITE(b2); mwA = mrow[j + 1]; SLOAD((j + 2) * KVBLK);
        __syncthreads();
        SBAR(); qkt(pA0, pA1, K_lds + b2 * SHM_K, qr, r32, hi);
        finishSM(pB0, pB1, alB, l_reg, pa0, pa1, pa2, pa3); SG_R1(); SBAR();
        BIAST(pA0, pA1, j + 1);
        SBAR(); pv_d0(o, vb0 + b1 * SHM_V, pa0, pa1, pa2, pa3); mask_tile(pA0, pA1, mwA, hi); partialSM(pA0, pA1, m_reg, mnA, alA); SG_R2(); SBAR();
        RESC(alA);
        SWRITE(b0); mwB = mrow[j + 2]; if (j + 3 < NT) SLOAD((j + 3) * KVBLK);
        __syncthreads();
        { const int t0_ = b0; b0 = b2; b2 = b1; b1 = t0_; }
        } else {
        if constexpr (PV_ON(2)) qkt(pB0, pB1, K_lds + b1 * SHM_K, qr, r32, hi);
        if constexpr (PV_ON(1)) { finishSM(pA0, pA1, alA, l_reg, pa0, pa1, pa2, pa3); BIAST(pB0, pB1, j); }
        if constexpr (PV_ON(2)) pv_d0(o, vb0 + b0 * SHM_V, pa0, pa1, pa2, pa3);
        if constexpr (PV_ON(1)) { mask_tile(pB0, pB1, mwB, hi); partialSM(pB0, pB1, m_reg, mnB, alB); RESC(alB); }
        if constexpr (PV_ON(4)) { SWRITE(b2); mwA = mrow[j + 1]; SLOAD((j + 2) * KVBLK); }
        __syncthreads();
        if constexpr (PV_ON(2)) qkt(pA0, pA1, K_lds + b2 * SHM_K, qr, r32, hi);
        if constexpr (PV_ON(1)) { finishSM(pB0, pB1, alB, l_reg, pa0, pa1, pa2, pa3); BIAST(pA0, pA1, j + 1); }
        if constexpr (PV_ON(2)) pv_d0(o, vb0 + b1 * SHM_V, pa0, pa1, pa2, pa3);
        if constexpr (PV_ON(1)) { mask_tile(pA0, pA1, mwA, hi); partialSM(pA0, pA1, m_reg, mnA, alA); RESC(alA); }
        if constexpr (PV_ON(4)) { SWRITE(b0); mwB = mrow[j + 2]; if (j + 3 < NT) SLOAD((j + 3) * KVBLK); }
        __syncthreads();
        { const int t0_ = b0; b0 = b2; b2 = b1; b1 = t0_; }
        }
    }
    SBAR(); qkt(pB0, pB1, K_lds + b1 * SHM_K, qr, r32, hi);
    finishSM(pA0, pA1, alA, l_reg, pa0, pa1, pa2, pa3); SG_R1(); SBAR();
    BIAST(pB0, pB1, NT - 1);
    SBAR(); pv_d0(o, vb0 + b0 * SHM_V, pa0, pa1, pa2, pa3); mask_tile(pB0, pB1, mwB, hi); partialSM(pB0, pB1, m_reg, mnB, alB); SG_R2(); SBAR();
    RESC(alB);
    finishSM(pB0, pB1, alB, l_reg, pa0, pa1, pa2, pa3); SBAR();
    pv_d0(o, vb0 + b1 * SHM_V, pa0, pa1, pa2, pa3);
#undef BIAST
#undef SG_R1
#undef SG_R2
    if (hi == 0) li_l[r32] = l_reg; asm volatile("s_waitcnt lgkmcnt(0)" ::: "memory");
    float rli[16];
#pragma unroll
    for (int r = 0; r < 16; ++r) rli[r] = __builtin_amdgcn_rcpf(li_l[crow(r, hi)]);
    bf16_t* Ow = mix + (size_t)(b * SEQ + 64 * n + 32 * qsub) * DM + hq * 128;
#pragma unroll
    for (int r = 0; r < 16; ++r) { const int orow = crow(r, hi);
#pragma unroll
        for (int d0 = 0; d0 < 4; ++d0) Ow[(size_t)orow * DM + d0 * 32 + r32] = (bf16_t)(cvt_pk_bf16(o[d0][r] * rli[r], 0.f) & 0xffffu); }
    __syncthreads();
#undef SLOAD
#undef SWRITE
#undef RESC
}
}

template <int PVAR> __device__ __forceinline__ void phase_attn(Ctx& C) {
    const int tidl = tid_l(), lane = tidl & 63; (void)lane;
    unsigned char* const wsl = launder(C.ws); unsigned* const ctll = (unsigned*)(wsl + WS_CTL); (void)ctll;
    const bf16_t* Q = (const bf16_t*)(wsl + WS_PROJ + PJ_Q); const bf16_t* K = (const bf16_t*)(wsl + WS_PROJ + PJ_K); const bf16_t* V = (const bf16_t*)(wsl + WS_PROJ + PJ_V);
    const unsigned long long* mask = (const unsigned long long*)(wsl + WS_MASK); bf16_t* mix = (bf16_t*)(wsl + WS_MIX);
    for (int p = C.bx; p < 256; p += C.G) { const int j = p >> 3, bk = p & 7;
        at::attn_unit<PVAR>(Q, K, V, mask, KIN(1), mix, bk >> 1, bk & 1, 63 - j, (LAS char*)C.lds);
        at::attn_unit<PVAR>(Q, K, V, mask, KIN(1), mix, bk >> 1, bk & 1, j, (LAS char*)C.lds); }
}

constexpr int NWAVES = 8;
constexpr int RING_BYTES = 131072, MISC_OFF = 143360, LDS_BYTES = 147456;
constexpr int PH_PER_LAYER = 10, NPH = 1 + NLAYER * PH_PER_LAYER;
#ifndef MK_PER_PHASE
#define MK_PER_PHASE 0
#endif


__device__ __forceinline__ Ctx make_ctx() {
    extern __shared__ __attribute__((aligned(16))) unsigned char lds_raw[];
    Ctx C; C.lds = (LAS unsigned char*)lds_raw; KArgs ka = kargs(); C.ws = as_global((unsigned char*)ka->ws); C.ctl = (unsigned*)(C.ws + WS_CTL);
    C.wave = __builtin_amdgcn_readfirstlane(tid_l() >> 6); int bx = (int)blockIdx.x; asm volatile("" : "+s"(bx)); C.bx = bx; C.G = gridDim.x; C.gw = bx * NWAVES + C.wave; C.NGW = C.G * NWAVES; return C;
}
__device__ __forceinline__ void seam() {
    extern __shared__ __attribute__((aligned(16))) unsigned char lds_raw[];
    XcdBarrier b; b.bar = as_global((unsigned*)((unsigned char*)kargs()->ws + WS_CTL) + CW_BAR); b.x = xb_xcc_id(); b.st = (volatile LAS unsigned*)((LAS unsigned char*)lds_raw + MISC_OFF) + 8;
    xcd_barrier(b);
}
#ifndef ONLY
#define ONLY -1
#endif
#define SITE(s) (ONLY < 0 || ONLY == (s))
#define IN(k) (kargs()->ph_lo <= (k) && (k) < kargs()->ph_hi)
#define SEAM(k) do { if (IN((k) + 1)) seam(); } while (0)
#ifndef PROBE_DUP
#define PROBE_DUP -1
#endif
#ifndef PROBE_DUP2
#define PROBE_DUP2 -1
#endif
#ifndef PROBE_DUP3
#define PROBE_DUP3 -1
#endif
#ifndef PROBE_DUP4
#define PROBE_DUP4 -1
#endif
#define DUPX(s)
#define DUP_UNUSED(s) for (int rep_ = 0; rep_ < ((PROBE_DUP == (s) || PROBE_DUP2 == (s) || PROBE_DUP3 == (s) || PROBE_DUP4 == (s)) ? 2 : 1); ++rep_)
#define CTX() Ctx C = make_ctx(); LAS unsigned char* const ring = C.lds; (void)ring
#define LSITE 0
template <int l, int PVAR> __device__ __forceinline__ void layer_program() {
    constexpr int pb = 1 + l * PH_PER_LAYER;
#define SUB_BEGIN { CTX(); unsigned char* const wsl = launder(C.ws); unsigned char* const pj = wsl + WS_PROJ; const float* const rstd = (const float*)(wsl + WS_SMALL + SM_RSTD); (void)pj; (void)rstd; (void)ring;
#define SUB_END }
#define SITE_BEGIN(sid, k) if (SITE(sid) && IN(pb + (k))) { SUB_BEGIN
#define SITE_END(k) SUB_END SEAM(pb + (k)); }
    if constexpr (l != 0) { SITE_BEGIN(0, 0) phase_rstd(C); SITE_END(0) }
    SITE_BEGIN(1, 1)
        SchedDense S{(const char*)(wsl + WS_HB8), (const char*)(wsl + WS_W_IN) + (size_t)l * INP * DM, DM, DM, NTOK / 256, INP / 256, DM / 128, C.G, C.bx};
        EpiInProj<true> E{pj, rstd, (const float*)(wsl + WS_ROPE), (const float*)(wsl + WS_ROPE) + SEQ * 128, (const float*)(wsl + WS_SMALL + SM_SA), (const float*)(wsl + WS_SMALL + SM_SBIN) + l * (INP / 256)};
        gm::gemm_phase<EpiInProj<true>, SchedDense, false, 2>(ring, S, E, DM, DM);
    SITE_END(1)
    SITE_BEGIN(2, 2) phase_scores(C); SUB_END
        SUB_BEGIN phase_post(C, l); SUB_END
        SUB_BEGIN SchedRetTile S{(const char*)(pj + PJ_QP), (const char*)(pj + PJ_RK), 256 * 512 * 2, 0, 4, C.G, C.bx, 256 * 1024 * 2};
          EpiRetP E{(bf16_t*)(pj + PJ_QP)};
          gm::gemm_phase<EpiRetP, SchedRetTile, false>(ring, S, E, 512 * 2, 1024 * 2); SUB_END
        SUB_BEGIN SchedRetTile S{(const char*)(pj + PJ_SV) + 512, (const char*)(pj + PJ_KT), 256 * 512 * 2, 256 * 256 * 2, 4, C.G, C.bx, 0};
          EpiRetKV E{(float*)(pj + PJ_KVT)};
          gm::gemm_phase<EpiRetKV, SchedRetTile, false>(ring, S, E, 512 * 2, 256 * 2);
    SITE_END(2)
    SITE_BEGIN(3, 3) phase_select(C); SUB_END SUB_BEGIN phase_retscan(C); SITE_END(3)
    SITE_BEGIN(4, 4) phase_attn<PVAR>(C); SUB_END
        SUB_BEGIN SchedRetTile S{(const char*)(pj + PJ_QP), (const char*)(pj + PJ_SV), 256 * 512 * 2, 256 * 512 * 2, 8, C.G, C.bx, 0};
          EpiRetOut E{(bf16_t*)(wsl + WS_MIX), (const bf16_t*)(pj + PJ_RG), KIN(6) + l * 1024, C.lds + RING_BYTES};
          gm::gemm_phase<EpiRetOut, SchedRetTile, false>(ring, S, E, 512 * 2, 512 * 2);
    SITE_END(4)
    SITE_BEGIN(5, 5)
        SchedDense S{(const char*)(wsl + WS_MIX), (const char*)(wsl + WS_W_OUT) + (size_t)l * DM * DM * 2, DM * 2, DM * 2, NTOK / 256, DM / 256, DM / 64, C.G, C.bx};
        EpiResid E{(l == 0) ? KIN(0) : (const float*)KOUT, KOUT, (bf16_t*)(wsl + WS_HB)};
        gm::gemm_phase<EpiResid, SchedDense, false>(ring, S, E, DM * 2, DM * 2);
    SITE_END(5)
    if constexpr (l == 0) {
        SITE_BEGIN(6, 6) phase_rstd(C); SITE_END(6)
        SITE_BEGIN(7, 7)
            SchedDense S{(const char*)(wsl + WS_HB8), (const char*)(wsl + WS_W_FUP), DM, DM, NTOK / 256, 2 * DFF / 256, DM / 128, C.G, C.bx};
            EpiFfnUp<true> E{(bf16_t*)(wsl + WS_BIG), rstd, (const float*)(wsl + WS_SMALL + SM_SA), (const float*)(wsl + WS_SMALL + SM_SBF)};
            gm::gemm_phase<EpiFfnUp<true>, SchedDense, false, 2>(ring, S, E, DM, DM);
        SITE_END(7)
        SITE_BEGIN(8, 8)
            SchedDense S{(const char*)(wsl + WS_BIG), (const char*)(wsl + WS_W_FDN), DFF * 2, DFF * 2, NTOK / 256, DM / 256, DFF / 64, C.G, C.bx};
            EpiResid E{KOUT, KOUT, (bf16_t*)(wsl + WS_HB)};
            gm::gemm_phase<EpiResid, SchedDense, false>(ring, S, E, DFF * 2, DFF * 2);
        SITE_END(8)
        if (SITE(9) && IN(pb + 9)) { SEAM(pb + 9); }
    } else {
        SITE_BEGIN(26, 6) phase_stats<true>(C, KOUT, l); SITE_END(6)
        SITE_BEGIN(27, 7)
            SchedMoeUp S{moe_info((unsigned*)(wsl + WS_CTL)), (const char*)(wsl + WS_HB8), (const char*)(wsl + WS_W_MUP), (const int*)(wsl + WS_SMALL + SM_LIST), C.G, C.bx};
            EpiMoeUp E{(unsigned char*)(wsl + WS_BIG), (const float*)(wsl + WS_SMALL + SM_RFAC), (const int*)(wsl + WS_SMALL + SM_LIST)};
            gm::gemm_phase<EpiMoeUp, SchedMoeUp, true, 1>(ring, S, E, DM, DM);
        SITE_END(7)
        SITE_BEGIN(28, 8)
            SchedMoeDown S{moe_info((unsigned*)(wsl + WS_CTL)), (const char*)(wsl + WS_BIG), (const char*)(wsl + WS_W_MDN), C.G, C.bx};
            EpiMoeDown E{(bf16_t*)(pj + PJ_Y)};
            gm::gemm_phase<EpiMoeDown, SchedMoeDown, false, 1>(ring, S, E, DFE, DFE);
        SITE_END(8)
        SITE_BEGIN(29, 9) phase_combine(C); SITE_END(9)
    }
#undef SITE_BEGIN
#undef SITE_END
#undef SUB_BEGIN
#undef SUB_END
}
template <int PVAR> __global__ void __launch_bounds__(NWAVES * 64, 2) mk_fwd_t(Args args) {
    extern __shared__ __attribute__((aligned(16))) unsigned char lds_raw[];
    {
        volatile LAS unsigned* MISC = (volatile LAS unsigned*)((LAS unsigned char*)lds_raw + MISC_OFF);
        if ((int)threadIdx.x < 32) MISC[(int)threadIdx.x] = 0u;
        __syncthreads();
        if (args.use_bar) (void)xcd_barrier_post((unsigned*)(args.ws + WS_CTL) + CW_BAR, MISC + 8);
    }

    if (SITE(100) && IN(0)) { { CTX(); phase_prepA(C); } { CTX(); phase_stats<false>(C, KIN(0), 0); } SEAM(0); }

    layer_program<0, PVAR>();
    layer_program<1, PVAR>();
#undef IN
#undef SEAM
}

extern "C" void kernel_launch(void* const* d_in, const int* in_sizes, int n_in, void* d_out, int out_size, void* d_ws, size_t ws_size, hipStream_t stream) {
    static int grid = 0;
    if (grid == 0) {
        if (n_in != 16 || out_size != NTOK * DM || ws_size < WS_END) { fprintf(stderr, "kernel_launch: unexpected shapes (n_in %d out %d ws %zu, need %zu)\n", n_in, out_size, ws_size, (size_t)WS_END); grid = -1; return; }
        int dev = 0, cus = 0, per_cu = 0;
        if (hipGetDevice(&dev) != hipSuccess || hipDeviceGetAttribute(&cus, hipDeviceAttributeMultiprocessorCount, dev) != hipSuccess) { grid = -1; return; }
        if (hipFuncSetAttribute((const void*)mk_fwd_t<0>, hipFuncAttributeMaxDynamicSharedMemorySize, LDS_BYTES) != hipSuccess) { fprintf(stderr, "kernel_launch: hipFuncSetAttribute failed\n"); grid = -1; return; }
        if (hipOccupancyMaxActiveBlocksPerMultiprocessor(&per_cu, (const void*)mk_fwd_t<0>, NWAVES * 64, LDS_BYTES) != hipSuccess || per_cu < 1) { fprintf(stderr, "kernel_launch: occupancy query says %d\n", per_cu); }
        (void)hipGetLastError();
        grid = cus;
    }
    if (grid < 0) return;
    if (hipMemsetAsync((char*)d_ws + WS_CTL, 0, CTL_ZERO_BYTES, stream) != hipSuccess) return;
    Args a{};
    for (int i = 0; i < 16; ++i) a.in[i] = (const float*)d_in[i];
    a.out = (float*)d_out; a.ws = (unsigned char*)d_ws; a.pad = 0;
#if MK_PER_PHASE
    for (int ph = 0; ph < NPH; ++ph) {
        if (ph == 1 + 9 || ph == 1) continue;
        a.ph_lo = ph; a.ph_hi = ph + 1; a.use_bar = 0;
#ifdef PROBE_PH
#ifndef PROBE_VAR
#define PROBE_VAR 0
#endif
        { const int pr[] = {PROBE_PH}; for (int q = 0; q < (int)(sizeof(pr) / sizeof(int)); ++q) if (pr[q] == ph) { hipFuncSetAttribute((const void*)mk_fwd_t<PROBE_VAR>, hipFuncAttributeMaxDynamicSharedMemorySize, LDS_BYTES); hipLaunchKernelGGL(mk_fwd_t<PROBE_VAR>, dim3(grid), dim3(NWAVES * 64), LDS_BYTES, stream, a); } }
#endif
        hipLaunchKernelGGL(mk_fwd_t<0>, dim3(grid), dim3(NWAVES * 64), LDS_BYTES, stream, a);

    }
#else
    a.ph_lo = 0; a.ph_hi = NPH; a.use_bar = 1;
    hipLaunchKernelGGL(mk_fwd_t<0>, dim3(grid), dim3(NWAVES * 64), LDS_BYTES, stream, a);
#endif
    const hipError_t le = hipPeekAtLastError();
    if (le != hipSuccess) fprintf(stderr, "kernel_launch: launch failed: %s\n", hipGetErrorName(le));
}
```

```cpp
#include <hip/hip_runtime.h>
#include <cstdio>
#include <cstdint>

#define LAS __attribute__((address_space(3)))
#define GAS __attribute__((address_space(1)))
typedef unsigned short bf16_t;
typedef short bf16x8 __attribute__((ext_vector_type(8)));
typedef short s16x4 __attribute__((ext_vector_type(4)));
typedef float f32x2 __attribute__((ext_vector_type(2)));
typedef float f32x4 __attribute__((ext_vector_type(4)));
typedef float f32x16 __attribute__((ext_vector_type(16)));
typedef unsigned u32x2 __attribute__((ext_vector_type(2)));
typedef unsigned u32x4 __attribute__((ext_vector_type(4)));
typedef int i32x8 __attribute__((ext_vector_type(8)));
typedef int i32x4 __attribute__((ext_vector_type(4)));

constexpr int DM = 2048, NBATCH = 4, SEQ = 4096, NTOK = NBATCH * SEQ;
constexpr int AH = 8, AKV = 2, AD = 128, IH = 16, IDIM = 64, RH = 4, RD = 256;
constexpr int INW = 6736, INP = 6912;
constexpr int DFF = 5632, NE = 8, DFE = 7168;
constexpr int NLAYER = 2;
constexpr float EPS = 1e-6f, GN_EPS = 1e-5f;
constexpr float LOG2E = 1.4426950408889634f;

constexpr size_t MiB = 1u << 20;
constexpr size_t WS_CTL = 0, CTL_ZERO_BYTES = 1 * MiB;
constexpr size_t WS_SMALL = 1 * MiB;
constexpr size_t WS_ROPE = 9 * MiB;
constexpr size_t WS_W_IN = 13 * MiB, WS_W_FUP = 83 * MiB, WS_W_OUT = 67 * MiB, WS_W_FDN = 127 * MiB, WS_W_MUP = 149 * MiB, WS_W_MDN = 373 * MiB;
constexpr size_t WS_HB = 485 * MiB, WS_HB8 = 549 * MiB, WS_MASK = 581 * MiB, WS_MIX = 589 * MiB, WS_PROJ = 653 * MiB, WS_BIG = 1024 * MiB, WS_END = 1280 * MiB;
constexpr float S_HB8 = 8.f, S_WUP8 = 64.f, S_H8 = 4.f, S_WDN8 = 128.f, S_MIX8 = 4.f, S_WOUT8 = 64.f;
constexpr size_t PJ_Q = 0, PJ_K = 32 * MiB, PJ_V = 40 * MiB, PJ_IQ = 48 * MiB, PJ_IK = 80 * MiB, PJ_IW = 82 * MiB, PJ_RG = 83 * MiB, PJ_QP = 115 * MiB,
                 PJ_SV = 179 * MiB, PJ_KT = 243 * MiB, PJ_RK = 275 * MiB, PJ_KVT = 307 * MiB;
constexpr size_t PJ_Y = 0;
constexpr size_t SM_RFAC = 2 * 1024 * 1024;
constexpr size_t SM_SA = 1024 * 1024, SM_SBIN = SM_SA + 64 * 1024, SM_SBF = SM_SBIN + 64 * 1024;
constexpr size_t SM_RSTD = 0, SM_TOKE = 64 * 1024, SM_TOKS = SM_TOKE + 128 * 1024, SM_TOKG = SM_TOKS + 128 * 1024, SM_LIST = SM_TOKG + 128 * 1024;
constexpr int CW_CNT = 64;
constexpr int CW_BAR = 4096;
constexpr int CW_QUEUE = 3072;
constexpr int CW_CMAX_IN = 16384, CW_CMAX_F = CW_CMAX_IN + 64;

typedef __bf16 bf16v2 __attribute__((ext_vector_type(2)));
__device__ __forceinline__ unsigned cvt_pk_bf16(float lo, float hi) { const f32x2 x = {lo, hi}; return __builtin_bit_cast(unsigned, __builtin_convertvector(x, bf16v2)); }
__device__ __forceinline__ unsigned cvt_pk4_fp8(float a, float b, float c, float d) { int w = __builtin_amdgcn_cvt_pk_fp8_f32(a, b, 0, false); w = __builtin_amdgcn_cvt_pk_fp8_f32(c, d, w, true); return (unsigned)w; }
__device__ __forceinline__ unsigned cvt_pk4_fp8c(float a, float b, float c, float d) { return cvt_pk4_fp8(__builtin_amdgcn_fmed3f(a, -448.f, 448.f), __builtin_amdgcn_fmed3f(b, -448.f, 448.f), __builtin_amdgcn_fmed3f(c, -448.f, 448.f), __builtin_amdgcn_fmed3f(d, -448.f, 448.f)); }
__device__ __forceinline__ unsigned pk4_i8(float a, float b, float c, float d) { return ((unsigned)__float2int_rn(a) & 255u) | (((unsigned)__float2int_rn(b) & 255u) << 8) | (((unsigned)__float2int_rn(c) & 255u) << 16) | ((unsigned)__float2int_rn(d) << 24); }
__device__ __forceinline__ float bf_lo(unsigned w) { return __uint_as_float(w << 16); }
__device__ __forceinline__ float bf_hi(unsigned w) { return __uint_as_float(w & 0xffff0000u); }
__device__ __forceinline__ float wave_sum(float v) {
#pragma unroll
    for (int o = 1; o < 64; o <<= 1) v += __shfl_xor(v, o);
    return v;
}
template <class T> __device__ __forceinline__ T* as_global(T* p) { return p; }
template <class T> __device__ __forceinline__ T* launder(T* p) { __attribute__((address_space(1))) T* g = (__attribute__((address_space(1))) T*)p; asm volatile("" : "+s"(g)); return (T*)g; }
__device__ __forceinline__ int tid_l() { int t = (int)threadIdx.x; asm volatile("" : "+v"(t)); return t; }
__device__ __forceinline__ void stagger(int bx, unsigned ticks) { const unsigned long long t0 = __builtin_amdgcn_s_memrealtime(); const unsigned long long d = (unsigned long long)(bx & 7) * ticks;
    while (__builtin_amdgcn_s_memrealtime() - t0 < d) __builtin_amdgcn_s_sleep(8); }
#define LDS_WAIT() asm volatile("s_waitcnt lgkmcnt(0)" ::: "memory")
#define VM_WAIT() asm volatile("s_waitcnt vmcnt(0)" ::: "memory")

#define XB_TMO      128
#define XB_XCNT(j)  (256  + 64 * (j))
#define XB_XSUB(j)  (1280 + 64 * (j))
#define XB_XGEN(j)  (2304 + 64 * (j))
#define XB_TOP      3328
#define XB_TOPGEN   3392
#define XCD_BAR_WORDS 3456
#define XB_SPIN_CAP (1u << 22)
__device__ __forceinline__ unsigned xb_ld(unsigned* p)              { return __hip_atomic_load(p, __ATOMIC_RELAXED, __HIP_MEMORY_SCOPE_AGENT); }
__device__ __forceinline__ unsigned xb_add(unsigned* p, unsigned v) { return __hip_atomic_fetch_add(p, v, __ATOMIC_RELAXED, __HIP_MEMORY_SCOPE_AGENT); }
__device__ __forceinline__ unsigned xb_xcc_id() { return (unsigned)__builtin_amdgcn_s_getreg((3 << 11) | 20) & 0xFu; }
#define XB_SPIN(cond, bar) do { unsigned _sp = 0; while (cond) { __builtin_amdgcn_s_sleep(1); \
    if ((++_sp & 255u) == 0u) { if (xb_ld(&(bar)[XB_TMO])) break; if (_sp > XB_SPIN_CAP) { atomicAdd(&(bar)[XB_TMO], 1u); break; } } } } while (0)
struct XcdBarrier { unsigned* bar; unsigned x; volatile LAS unsigned* st; };
__device__ __forceinline__ XcdBarrier xcd_barrier_post(unsigned* bar, volatile LAS unsigned* st) {
    XcdBarrier b; b.bar = bar; b.x = xb_xcc_id(); b.st = st;
    if (threadIdx.x == 0) (void)xb_add(&bar[XB_XCNT(b.x)], 1u);
    return b;
}
__device__ __forceinline__ void xcd_barrier_complete(unsigned* bar, unsigned x, unsigned& nloc, unsigned& nx) {
    const unsigned G = gridDim.x * gridDim.y * gridDim.z;
    unsigned sum, cnt, mine, sp = 0u;
    for (;;) {
        sum = 0u; cnt = 0u; mine = 0u;
#pragma unroll
        for (unsigned j = 0; j < 16; ++j) { const unsigned c = xb_ld(&bar[XB_XCNT(j)]); sum += c; cnt += (c > 0u) ? 1u : 0u; mine = (j == x) ? c : mine; }
        if (sum == G) break;
        __builtin_amdgcn_s_sleep(1);
        if ((++sp & 255u) == 0u) { if (xb_ld(&bar[XB_TMO])) break; if (sp > XB_SPIN_CAP) { atomicAdd(&bar[XB_TMO], 1u); break; } }
    }
    nloc = mine > 0u ? mine : 1u; nx = cnt > 0u ? cnt : 1u;
}
__device__ __forceinline__ void xcd_barrier(const XcdBarrier& b) {
    asm volatile("s_waitcnt vmcnt(0)" ::: "memory");
    __syncthreads();
    if (threadIdx.x == 0) {
        unsigned* bar = launder(b.bar); unsigned bx = b.x; asm volatile("" : "+s"(bx));
        __builtin_amdgcn_s_waitcnt(0);
        unsigned nloc = b.st[0], nx = b.st[1];
        if (nloc == 0u) { xcd_barrier_complete(bar, bx, nloc, nx); b.st[0] = nloc; b.st[1] = nx; }
        const unsigned old = xb_add(&bar[XB_XSUB(bx)], 1u);
        const unsigned gen = old / nloc;
        if (old + 1u == (gen + 1u) * nloc) {
            __builtin_amdgcn_fence(__ATOMIC_RELEASE, "agent");
            asm volatile("s_waitcnt vmcnt(0)" ::: "memory");
            const unsigned og = xb_add(&bar[XB_TOP], 1u);
            const unsigned tg = og / nx;
            if (og + 1u == (tg + 1u) * nx) xb_add(&bar[XB_TOPGEN], 1u);
            else XB_SPIN(xb_ld(&bar[XB_TOPGEN]) == tg, bar);
            __builtin_amdgcn_fence(__ATOMIC_ACQUIRE, "agent");
            xb_add(&bar[XB_XGEN(bx)], 1u);
            asm volatile("s_waitcnt vmcnt(0)" ::: "memory");
        } else {
            XB_SPIN(xb_ld(&bar[XB_XGEN(bx)]) == gen, bar);
            __builtin_amdgcn_fence(__ATOMIC_ACQUIRE, "agent");
            asm volatile("s_waitcnt vmcnt(0)" ::: "memory");
        }
    }
    __syncthreads();
}

namespace gm {
constexpr int BM = 256, BK = 64, HALF = 128, HTB = HALF * BK * 2, STAGE_BYTES = 8 * HTB, NXCD = 8, WGM = 4;
__host__ __device__ __forceinline__ int lds_byte(int r, int c) { const int st = (r >> 4) * 2 + (c >> 5), rr = r & 15, cc = c & 31, ob = rr * 64 + cc * 2; return st * 1024 + (ob ^ (((ob >> 9) & 1) << 5)); }
__host__ __device__ __forceinline__ void stage_rc(int b, int& R, int& C) { const int st = b / 1024, sb = b % 1024, swz = sb ^ (((sb >> 9) & 1) << 5); R = (st >> 1) * 16 + swz / 64; C = (st & 1) * 32 + (swz % 64) / 2; }
__host__ __device__ __forceinline__ int perm32(int rho) { const int n = rho >> 4, i = rho & 15; return 8 * (i >> 2) + 4 * n + (i & 3); }

struct Unit { const char* A; const char* B; const int* rows; int pm, pn, nt, aux; };

__device__ __forceinline__ bool tile_order(long L, int nM, int nN, int& pm, int& pn) {
    const int nwg = nM * nN; if (L >= nwg) return false;
    int wgid = (int)L; { const int q = nwg / NXCD, r = nwg % NXCD, xcd = wgid % NXCD, off = wgid / NXCD; wgid = (xcd < r ? xcd * (q + 1) : r * (q + 1) + (xcd - r) * q) + off; }
    const int nig = WGM * nN, gid = wgid / nig, fm = gid * WGM, gsz = (nM - fm) < WGM ? (nM - fm) : WGM;
    pm = fm + ((wgid % nig) % gsz); pn = (wgid % nig) / gsz; return true;
}

template <class Epi, class Sched, bool GATHER, int MODE = 0, int GPV = 0>
__device__ __forceinline__ void gemm_phase(LAS unsigned char* lds, const Sched& S, const Epi& E, const unsigned lda, const unsigned ldb) {
    const int tid = tid_l(), wid = __builtin_amdgcn_readfirstlane(tid >> 6), lane = tid & 63, wr = wid >> 2, wc = wid & 3, fr = lane & 15, fq = lane >> 4;
    int Rr[2]; unsigned Cc[2], voffB[2];
#pragma unroll
    for (int i = 0; i < 2; ++i) { int R, C; stage_rc(tid * 16 + i * 8192, R, C); const int Rb = Epi::PERM ? ((R & ~31) + perm32(R & 31)) : R;
        Rr[i] = R; Cc[i] = (unsigned)C * 2u; voffB[i] = (unsigned)Rb * ldb + (unsigned)C * 2u; }
    const size_t kstep = (size_t)(BK * 2);
    const size_t hstepB = (size_t)HALF * ldb, hstepA = GATHER ? 0 : (size_t)HALF * lda;
    const unsigned ldsw = (unsigned)wid * 1024u;
    const int aoff = lds_byte(wr * 64 + fr, fq * 8), boff = lds_byte(wc * 32 + fr, fq * 8);
#define GM_SA(b, h) (((b) * 2 + (h)) * HTB)
#define GM_SB(b, h) ((4 + (b) * 2 + (h)) * HTB)
#define GM_STAGE_A(bufoff, gbase, offs) do { if constexpr (GPV & 4) break; _Pragma("unroll") for (int _i = 0; _i < 2; ++_i) \
        __builtin_amdgcn_global_load_lds((const unsigned*)((const char*)(gbase) + (offs)[_i]), (LAS unsigned*)(lds + (bufoff) + ldsw + _i * 8192), 16, 0, 0); } while (0)
#define GM_STAGE_B(bufoff, gbase) do { if constexpr (GPV & 4) break; _Pragma("unroll") for (int _i = 0; _i < 2; ++_i) \
        __builtin_amdgcn_global_load_lds((const unsigned*)((const char*)(gbase) + voffB[_i]), (LAS unsigned*)(lds + (bufoff) + ldsw + _i * 8192), 16, 0, 0); } while (0)
#define GM_LDA(dst, b, h) do { _Pragma("unroll") for (int m = 0; m < 4; ++m) _Pragma("unroll") for (int k = 0; k < 2; ++k) dst[m][k] = *(const LAS bf16x8*)(lds + GM_SA(b, h) + aoff + m * 2048 + k * 1024); } while (0)
#define GM_LDB(dst, b, h) do { _Pragma("unroll") for (int n = 0; n < 2; ++n) _Pragma("unroll") for (int k = 0; k < 2; ++k) dst[n][k] = *(const LAS bf16x8*)(lds + GM_SB(b, h) + boff + n * 2048 + k * 1024); } while (0)
#define GM_MMA(ai, bj, At, Bt) do { if constexpr (GPV & 2) { _Pragma("unroll") for (int m = 0; m < 4; ++m) asm volatile("" :: "v"(At[m][0]), "v"(At[m][1])); _Pragma("unroll") for (int n = 0; n < 2; ++n) asm volatile("" :: "v"(Bt[n][0]), "v"(Bt[n][1])); break; } __builtin_amdgcn_s_setprio(1); _Pragma("unroll") for (int m = 0; m < 4; ++m) _Pragma("unroll") for (int n = 0; n < 2; ++n) { \
        if constexpr (MODE == 1) { const i32x8 b8_ = __builtin_shufflevector(__builtin_bit_cast(i32x4, Bt[n][0]), __builtin_bit_cast(i32x4, Bt[n][1]), 0, 1, 2, 3, 4, 5, 6, 7); \
            const i32x8 a8_ = __builtin_shufflevector(__builtin_bit_cast(i32x4, At[m][0]), __builtin_bit_cast(i32x4, At[m][1]), 0, 1, 2, 3, 4, 5, 6, 7); \
            asm volatile("v_mfma_scale_f32_16x16x128_f8f6f4 %0, %1, %2, %0, %3, %3 op_sel_hi:[0,0,0]" : "+v"(acc[ai][bj][m][n]) : "v"(b8_), "v"(a8_), "v"(sc1_)); } \
        else if constexpr (MODE == 2) { i32x4 ci_ = __builtin_bit_cast(i32x4, acc[ai][bj][m][n]); \
            _Pragma("unroll") for (int k = 0; k < 2; ++k) ci_ = __builtin_amdgcn_mfma_i32_16x16x64_i8(__builtin_bit_cast(i32x4, Bt[n][k]), __builtin_bit_cast(i32x4, At[m][k]), ci_, 0, 0, 0); \
            acc[ai][bj][m][n] = __builtin_bit_cast(f32x4, ci_); } \
        else { _Pragma("unroll") for (int k = 0; k < 2; ++k) acc[ai][bj][m][n] = __builtin_amdgcn_mfma_f32_16x16x32_bf16(Bt[n][k], At[m][k], acc[ai][bj][m][n], 0, 0, 0); } } \
        __builtin_amdgcn_s_setprio(0); } while (0)
#define GM_WAIT_V(n) asm volatile("s_waitcnt vmcnt(" #n ")" ::: "memory")
#define GM_WAIT_L(n) asm volatile("s_waitcnt lgkmcnt(" #n ")" ::: "memory")
#define GM_BAR __builtin_amdgcn_s_barrier()
#define GM_SCHED __builtin_amdgcn_sched_barrier(0)
    Unit cur, nxt; int ui = 0;
    if (!S.next(0, cur)) return;
    f32x4 acc[2][2][4][2];
#pragma unroll
    for (int a = 0; a < 2; ++a)
#pragma unroll
        for (int b = 0; b < 2; ++b)
#pragma unroll
            for (int m = 0; m < 4; ++m)
#pragma unroll
                for (int n = 0; n < 2; ++n) acc[a][b][m][n] = (f32x4){0.f, 0.f, 0.f, 0.f};
    bf16x8 At[4][2], B0[2][2], B1[2][2];
    const int sc1_ = 0x7F7F7F7F; (void)sc1_;
    unsigned aoC[2][2], aoN[2][2]; int rowN[2][2];
#pragma unroll
    for (int h = 0; h < 2; ++h)
#pragma unroll
        for (int i = 0; i < 2; ++i) { const int row = h * HALF + Rr[i]; const int rr = GATHER ? cur.rows[row] : Rr[i]; aoC[h][i] = (unsigned)rr * lda + Cc[i]; aoN[h][i] = aoC[h][i]; rowN[h][i] = 0; }
    const char* cA = cur.A; const char* cB = cur.B;
    GM_STAGE_B(GM_SB(0, 0), cB); GM_STAGE_B(GM_SB(0, 1), cB + hstepB); GM_STAGE_A(GM_SA(0, 0), cA, aoC[0]); GM_STAGE_A(GM_SA(0, 1), cA + hstepA, aoC[1]);
    if (wr == 1) GM_BAR;
    GM_WAIT_V(2); GM_BAR;
    GM_STAGE_B(GM_SB(1, 0), cB + kstep); GM_STAGE_A(GM_SA(1, 0), cA + kstep, aoC[0]); GM_STAGE_B(GM_SB(1, 1), cB + hstepB + kstep);
    GM_WAIT_V(6); GM_BAR;
    for (;;) {
        const bool has_next = S.next(ui + 1, nxt);
        const char* nA = has_next ? nxt.A : cA; const char* nB = has_next ? nxt.B : cB;
        if constexpr (GATHER) { if (has_next) {
#pragma unroll
            for (int h = 0; h < 2; ++h)
#pragma unroll
                for (int i = 0; i < 2; ++i) rowN[h][i] = nxt.rows[h * HALF + Rr[i]]; } }
        const int nt = cur.nt;
        for (int t = 0; t < nt; t += 2) {
            const bool last = (t == nt - 2);
            const char* a1 = cA + (size_t)(t + 1) * kstep;
            const char* a2 = last ? nA : cA + (size_t)(t + 2) * kstep; const char* b2 = last ? nB : cB + (size_t)(t + 2) * kstep;
            const char* a3 = a2 + kstep; const char* b3 = b2 + kstep;
            unsigned o2[2][2];
            if constexpr (GATHER) {
                if (last && has_next) {
#pragma unroll
                    for (int h = 0; h < 2; ++h)
#pragma unroll
                        for (int i = 0; i < 2; ++i) aoN[h][i] = (unsigned)rowN[h][i] * lda + Cc[i];
                }
#pragma unroll
                for (int h = 0; h < 2; ++h)
#pragma unroll
                    for (int i = 0; i < 2; ++i) o2[h][i] = last ? aoN[h][i] : aoC[h][i];
            } else {
#pragma unroll
                for (int h = 0; h < 2; ++h)
#pragma unroll
                    for (int i = 0; i < 2; ++i) o2[h][i] = aoC[0][i];
            }
            GM_LDB(B0, 0, 0); GM_LDB(B1, 0, 1); GM_SCHED; GM_LDA(At, 0, 0); GM_STAGE_A(GM_SA(1, 1), a1 + hstepA, aoC[1]);
            GM_WAIT_V(8); GM_WAIT_L(0); GM_BAR; GM_MMA(0, 0, At, B0); GM_MMA(0, 1, At, B1); GM_BAR; GM_SCHED;
            GM_LDA(At, 0, 1); GM_STAGE_B(GM_SB(0, 0), b2); GM_STAGE_B(GM_SB(0, 1), b2 + hstepB); GM_STAGE_A(GM_SA(0, 0), a2, o2[0]);
            GM_WAIT_V(8); GM_WAIT_L(0); GM_BAR; GM_MMA(1, 0, At, B0); GM_MMA(1, 1, At, B1); GM_BAR; GM_SCHED;
            GM_LDB(B0, 1, 0); GM_LDB(B1, 1, 1); GM_SCHED; GM_LDA(At, 1, 0); GM_STAGE_A(GM_SA(0, 1), a2 + hstepA, o2[1]);
            GM_WAIT_V(8); GM_WAIT_L(0); GM_BAR; GM_MMA(0, 0, At, B0); GM_MMA(0, 1, At, B1); GM_BAR; GM_SCHED;
            GM_LDA(At, 1, 1); GM_STAGE_B(GM_SB(1, 0), b3); GM_STAGE_B(GM_SB(1, 1), b3 + hstepB); GM_STAGE_A(GM_SA(1, 0), a3, o2[0]);
            GM_WAIT_V(8); GM_WAIT_L(0); GM_BAR; GM_MMA(1, 0, At, B0); GM_MMA(1, 1, At, B1); GM_BAR; GM_SCHED;
        }
        if (wr == 0) GM_BAR;
        if constexpr (MODE == 1) asm volatile("s_nop 7\n\ts_nop 7\n\ts_nop 7" ::: "memory");
        if constexpr (GPV & 8) { Unit uf_ = cur; uf_.pm = 0; E(acc, uf_, wr, wc, fr, fq); }
        else if constexpr (!(GPV & 1)) E(acc, cur, wr, wc, fr, fq);
        else { _Pragma("unroll") for (int a = 0; a < 2; ++a) _Pragma("unroll") for (int b = 0; b < 2; ++b) _Pragma("unroll") for (int m = 0; m < 4; ++m) asm volatile("" :: "v"(acc[a][b][m][0]), "v"(acc[a][b][m][1])); }
        if (!has_next) break;
#pragma unroll
        for (int a = 0; a < 2; ++a)
#pragma unroll
            for (int b = 0; b < 2; ++b)
#pragma unroll
                for (int m = 0; m < 4; ++m)
#pragma unroll
                    for (int n = 0; n < 2; ++n) acc[a][b][m][n] = (f32x4){0.f, 0.f, 0.f, 0.f};
        cur = nxt; cA = nA; cB = nB; ++ui;
        if constexpr (GATHER) {
#pragma unroll
            for (int h = 0; h < 2; ++h)
#pragma unroll
                for (int i = 0; i < 2; ++i) aoC[h][i] = aoN[h][i];
        }
        if (wr == 1) GM_BAR;
    }
    GM_WAIT_V(0);
    GM_BAR;
#undef GM_SA
#undef GM_SB
#undef GM_STAGE_A
#undef GM_STAGE_B
#undef GM_LDA
#undef GM_LDB
#undef GM_MMA
#undef GM_WAIT_V
#undef GM_WAIT_L
#undef GM_BAR
#undef GM_SCHED
}
}

typedef f32x4 Acc[2][2][4][2];
__device__ __forceinline__ u32x4 pack8(const f32x4 a, const f32x4 b) { u32x4 w; w.x = cvt_pk_bf16(a[0], a[1]); w.y = cvt_pk_bf16(a[2], a[3]); w.z = cvt_pk_bf16(b[0], b[1]); w.w = cvt_pk_bf16(b[2], b[3]); return w; }
__device__ __forceinline__ float silu_f(float g) { return g * __builtin_amdgcn_rcpf(1.0f + __builtin_amdgcn_exp2f(-g * LOG2E)); }

template <bool I8> __device__ __forceinline__ f32x4 accv(const f32x4& a) {
    if constexpr (I8) { const i32x4 i = __builtin_bit_cast(i32x4, a); return (f32x4){(float)i[0], (float)i[1], (float)i[2], (float)i[3]}; } else return a; }

struct SchedDense {
    const char* A; const char* B; unsigned lda, ldb; int nM, nN, nt, G, c;
    __device__ __forceinline__ bool next(int i, gm::Unit& u) const {
        int pm, pn; if (!gm::tile_order((long)i * G + c, nM, nN, pm, pn)) return false;
        u.pm = pm; u.pn = pn; u.nt = nt; u.aux = 0; u.rows = nullptr;
        u.A = A + (size_t)pm * 256 * lda; u.B = B + (size_t)pn * 256 * ldb; return true;
    }
};

__device__ __forceinline__ u32x4 tr8x8(u32x4 w, int fr) {
    const bool h4 = (fr & 4) != 0, h2 = (fr & 2) != 0, h1 = (fr & 1) != 0;
    { const unsigned s0 = h4 ? w[0] : w[2], s1 = h4 ? w[1] : w[3]; const unsigned r0 = __shfl_xor(s0, 4), r1 = __shfl_xor(s1, 4);
      if (h4) { w[0] = r0; w[1] = r1; } else { w[2] = r0; w[3] = r1; } }
    { const unsigned s0 = h2 ? w[0] : w[1], s1 = h2 ? w[2] : w[3]; const unsigned r0 = __shfl_xor(s0, 2), r1 = __shfl_xor(s1, 2);
      if (h2) { w[0] = r0; w[2] = r1; } else { w[1] = r0; w[3] = r1; } }
#pragma unroll
    for (int q = 0; q < 4; ++q) { const unsigned r = __shfl_xor(w[q], 1); w[q] = h1 ? ((r >> 16) | (w[q] & 0xffff0000u)) : ((w[q] & 0xffffu) | (r << 16)); }
    return w;
}
template <bool I8> struct EpiInProj {
    static constexpr bool PERM = true;
    unsigned char* pj; const float* rstd; const float* ropec; const float* ropes; const float* sa; const float* sb;
    __device__ __forceinline__ void operator()(const Acc& acc, const gm::Unit& u, int wr, int wc, int fr, int fq) const {
        int frl = fr, fql = fq; asm volatile("" : "+v"(frl), "+v"(fql));
        const int pn = u.pn, row0 = u.pm * 256 + wr * 64 + frl, cw = wc * 32 + 8 * fql;
        float rs[2][4];
#pragma unroll
        for (int ai = 0; ai < 2; ++ai)
#pragma unroll
            for (int m = 0; m < 4; ++m) { const int row = row0 + ai * 128 + m * 16; rs[ai][m] = I8 ? rstd[row] * sa[row] * sb[pn] : rstd[row]; }
#define AV(ai, bj, m, n) accv<I8>(acc[ai][bj][m][n])
        if (pn == 10) {
            bf16_t* ik = (bf16_t*)(pj + PJ_IK); float* iw = (float*)(pj + PJ_IW);
#pragma unroll
            for (int ai = 0; ai < 2; ++ai)
#pragma unroll
                for (int m = 0; m < 4; ++m) { const int row = row0 + ai * 128 + m * 16; const float r = rs[ai][m];
                    if (wc < 2) *(u32x4*)(ik + (size_t)row * 64 + cw) = pack8(AV(ai, 0, m, 0) * r, AV(ai, 0, m, 1) * r);
                    else if (wc == 2 && fq < 2) { *(f32x4*)(iw + (size_t)row * 16 + 8 * fq) = AV(ai, 0, m, 0) * r; *(f32x4*)(iw + (size_t)row * 16 + 8 * fq + 4) = AV(ai, 0, m, 1) * r; } }
            return;
        }
        if (pn >= 11 && pn < 19) {
            const bool isk = pn >= 15; const int h = isk ? pn - 15 : pn - 11; const size_t tile = (size_t)u.pm * 4 + h;
            const float lg2 = __builtin_log2f(1.0f - __builtin_exp2f(-5.0f - (float)h));
            bf16_t* qp = (bf16_t*)(pj + PJ_QP) + tile * 256 * 512; bf16_t* rk = (bf16_t*)(pj + PJ_RK) + h * 256; bf16_t* kt = (bf16_t*)(pj + PJ_KT) + tile * 256 * 256;
#pragma unroll
            for (int ai = 0; ai < 2; ++ai)
#pragma unroll
                for (int m = 0; m < 4; ++m) { const int row = row0 + ai * 128 + m * 16, pos = row & (SEQ - 1), i = row & 255;
                    const float r = rs[ai][m] * (isk ? 0.0625f * __builtin_amdgcn_exp2f(lg2 * (float)(255 - i)) : __builtin_amdgcn_exp2f(lg2 * (float)(i + 1)));
                    const f32x4 c0 = *(const f32x4*)(ropec + pos * 128 + cw), c1 = *(const f32x4*)(ropec + pos * 128 + cw + 4);
                    const f32x4 s0 = *(const f32x4*)(ropes + pos * 128 + cw), s1 = *(const f32x4*)(ropes + pos * 128 + cw + 4);
                    const f32x4 x10 = AV(ai, 0, m, 0) * r, x11 = AV(ai, 0, m, 1) * r, x20 = AV(ai, 1, m, 0) * r, x21 = AV(ai, 1, m, 1) * r;
                    const u32x4 w1 = pack8(x10 * c0 - x20 * s0, x11 * c1 - x21 * s1), w2 = pack8(x10 * s0 + x20 * c0, x11 * s1 + x21 * c1);
                    if (!isk) { bf16_t* rowp = qp + (size_t)i * 512 + cw; *(u32x4*)(rowp) = w1; *(u32x4*)(rowp + 128) = w2; }
                    else { bf16_t* rowp = rk + (size_t)row * 1024 + cw; *(u32x4*)(rowp) = w1; *(u32x4*)(rowp + 128) = w2;
                        bf16_t* tp = kt + (size_t)(cw + (frl & 7)) * 256 + (i - (frl & 7));
                        *(u32x4*)tp = tr8x8(w1, frl); *(u32x4*)(tp + 128 * 256) = tr8x8(w2, frl); }
                    asm volatile("" ::: "memory"); }
            return;
        }
        if (pn >= 19 && pn < 23) {
            const int h = pn - 19; const size_t tile = (size_t)u.pm * 4 + h; bf16_t* sv = (bf16_t*)(pj + PJ_SV) + tile * 256 * 512 + 256;
#pragma unroll
            for (int ai = 0; ai < 2; ++ai)
#pragma unroll
                for (int m = 0; m < 4; ++m) { const int row = row0 + ai * 128 + m * 16, i = row & 255; const float r = rs[ai][m];
#pragma unroll
                    for (int bj = 0; bj < 2; ++bj) { const u32x4 w = pack8(AV(ai, bj, m, 0) * r, AV(ai, bj, m, 1) * r);
                        *(u32x4*)(sv + (size_t)(bj * 128 + cw + (frl & 7)) * 512 + (i - (frl & 7))) = tr8x8(w, frl); }
                    asm volatile("" ::: "memory"); }
            return;
        }
        bf16_t* dst; int ld;
        if (pn < 4) { dst = (bf16_t*)(pj + PJ_Q) + pn * 256; ld = 1024; }
        else if (pn == 4) { dst = (bf16_t*)(pj + PJ_K); ld = 256; }
        else if (pn == 5) { dst = (bf16_t*)(pj + PJ_V); ld = 256; }
        else if (pn < 10) { dst = (bf16_t*)(pj + PJ_IQ) + (pn - 6) * 256; ld = 1024; }
        else { dst = (bf16_t*)(pj + PJ_RG) + (pn - 23) * 256; ld = 1024; }
#pragma unroll
        for (int ai = 0; ai < 2; ++ai)
#pragma unroll
            for (int m = 0; m < 4; ++m) { const int row = row0 + ai * 128 + m * 16; const float r = rs[ai][m]; bf16_t* rowp = dst + (size_t)row * ld + cw;
#pragma unroll
                for (int bj = 0; bj < 2; ++bj) *(u32x4*)(rowp + bj * 128) = pack8(AV(ai, bj, m, 0) * r, AV(ai, bj, m, 1) * r); }
    }
};
#undef AV

template <bool SRC32> struct EpiResid {
    static constexpr bool PERM = true;
    const float* src; bf16_t* hb; float sc;
    __device__ __forceinline__ void operator()(const Acc& acc, const gm::Unit& u, int wr, int wc, int fr, int fq) const {
        const int row0 = u.pm * 256 + wr * 64 + fr, col0 = u.pn * 256 + wc * 32 + 8 * fq;
#pragma unroll
        for (int ai = 0; ai < 2; ++ai)
#pragma unroll
            for (int m = 0; m < 4; ++m) { const size_t off = (size_t)(row0 + ai * 128 + m * 16) * DM + col0;
#pragma unroll
                for (int bj = 0; bj < 2; ++bj) { f32x4 b0, b1;
                    if constexpr (SRC32) { b0 = *(const f32x4*)(src + off + bj * 128); b1 = *(const f32x4*)(src + off + bj * 128 + 4); }
                    else { const u32x4 w = *(const u32x4*)(hb + off + bj * 128); b0 = (f32x4){bf_lo(w.x), bf_hi(w.x), bf_lo(w.y), bf_hi(w.y)}; b1 = (f32x4){bf_lo(w.z), bf_hi(w.z), bf_lo(w.w), bf_hi(w.w)}; }
                    *(u32x4*)(hb + off + bj * 128) = pack8(b0 + acc[ai][bj][m][0] * sc, b1 + acc[ai][bj][m][1] * sc); }
                asm volatile("" ::: "memory"); }
    }
};

template <bool I8> struct EpiFfnUp {
    static constexpr bool PERM = true;
    unsigned char* H; const float* rstd; const float* sa; const float* sb;
    __device__ __forceinline__ void operator()(const Acc& acc, const gm::Unit& u, int wr, int wc, int fr, int fq) const {
        const int row0 = u.pm * 256 + wr * 64 + fr, col0 = u.pn * 128 + wc * 32 + 8 * fq;
#pragma unroll
        for (int ai = 0; ai < 2; ++ai)
#pragma unroll
            for (int m = 0; m < 4; ++m) { const int row = row0 + ai * 128 + m * 16; const float r = I8 ? rstd[row] * sa[row] * sb[u.pn] : rstd[row]; f32x4 o[2]; const float ra = r * -LOG2E, c2 = r * r * S_H8;
#pragma unroll
                for (int n = 0; n < 2; ++n) { const f32x4 g4 = accv<I8>(acc[ai][0][m][n]), u4 = accv<I8>(acc[ai][1][m][n]);
#pragma unroll
                    for (int e = 0; e < 4; ++e) o[n][e] = (g4[e] * u4[e]) * (c2 * __builtin_amdgcn_rcpf(1.0f + __builtin_amdgcn_exp2f(g4[e] * ra))); }
                u32x2 w; w.x = cvt_pk4_fp8c(o[0][0], o[0][1], o[0][2], o[0][3]); w.y = cvt_pk4_fp8c(o[1][0], o[1][1], o[1][2], o[1][3]);
                *(u32x2*)(H + (size_t)row * DFF + col0) = w; asm volatile("" ::: "memory"); }
    }
};

struct SchedRetTile {
    const char* A; const char* B; size_t strideA, strideB; int nt, G, c, bstep_row;
    __device__ __forceinline__ bool next(int i, gm::Unit& u) const {
        const int L = i * G + c; if (L >= 256) return false;
        u.pm = L >> 2; u.pn = 0; u.nt = nt; u.aux = L; u.rows = nullptr;
        u.A = A + (size_t)L * strideA; u.B = bstep_row ? B + (size_t)(L >> 2) * bstep_row + (size_t)(L & 3) * 512 : B + (size_t)L * strideB; return true;
    }
};
struct EpiRetP {
    static constexpr bool PERM = true;
    bf16_t* QP;
    __device__ __forceinline__ void operator()(const Acc& acc, const gm::Unit& u, int wr, int wc, int fr, int fq) const {
        const int h = u.aux & 3; const float gi = __builtin_amdgcn_exp2f(-256.0f * __builtin_log2f(1.0f - __builtin_exp2f(-5.0f - (float)h)));
        bf16_t* Pb = QP + (size_t)u.aux * 256 * 512 + 256;
        int t0 = wr * 64 + fr; const int s0 = wc * 32 + 8 * fq; asm volatile("" : "+v"(t0));
#pragma unroll
        for (int ai = 0; ai < 2; ++ai)
#pragma unroll
            for (int m = 0; m < 4; ++m) { const int t = t0 + ai * 128 + m * 16;
#pragma unroll
                for (int bj = 0; bj < 2; ++bj) { const int d0 = t - (s0 + bj * 128); f32x4 o[2];
#pragma unroll
                    for (int n = 0; n < 2; ++n)
#pragma unroll
                        for (int e = 0; e < 4; ++e) o[n][e] = (d0 - (4 * n + e) >= 0) ? acc[ai][bj][m][n][e] * gi : 0.f;
                    *(u32x4*)(Pb + (size_t)t * 512 + s0 + bj * 128) = pack8(o[0], o[1]); }
                asm volatile("" ::: "memory"); }
    }
};
struct EpiRetKV {
    static constexpr bool PERM = false;
    float* KVT;
    __device__ __forceinline__ void operator()(const Acc& acc, const gm::Unit& u, int wr, int wc, int fr, int fq) const {
        float* base = KVT + (size_t)u.aux * 65536; const int row0 = wr * 64 + fr, col0 = wc * 32 + 4 * fq;
#pragma unroll
        for (int ai = 0; ai < 2; ++ai)
#pragma unroll
            for (int m = 0; m < 4; ++m) { float* rowp = base + (size_t)(row0 + ai * 128 + m * 16) * 256 + col0;
#pragma unroll
                for (int bj = 0; bj < 2; ++bj)
#pragma unroll
                    for (int n = 0; n < 2; ++n) *(f32x4*)(rowp + bj * 128 + n * 16) = acc[ai][bj][m][n];
                asm volatile("" ::: "memory"); }
    }
};
struct EpiRetOut {
    static constexpr bool PERM = true;
    unsigned char* mix; const bf16_t* rg; const float* gn; LAS unsigned char* xl;
    __device__ __forceinline__ void operator()(const Acc& acc, const gm::Unit& u, int wr, int wc, int fr, int fq) const {
        const int tile = u.aux, h = tile & 3; LAS f32x2* P = (LAS f32x2*)xl;
        const int lr0 = wr * 64 + fr;
#pragma unroll
        for (int ai = 0; ai < 2; ++ai)
#pragma unroll
            for (int m = 0; m < 4; ++m) { float s1 = 0.f, s2 = 0.f;
#pragma unroll
                for (int bj = 0; bj < 2; ++bj)
#pragma unroll
                    for (int n = 0; n < 2; ++n) { const f32x4 x = acc[ai][bj][m][n]; s1 += (x[0] + x[1]) + (x[2] + x[3]); s2 += (x[0] * x[0] + x[1] * x[1]) + (x[2] * x[2] + x[3] * x[3]); }
                s1 += __shfl_xor(s1, 16); s1 += __shfl_xor(s1, 32); s2 += __shfl_xor(s2, 16); s2 += __shfl_xor(s2, 32);
                if (fq == 0) P[(lr0 + ai * 128 + m * 16) * 4 + wc] = (f32x2){s1, s2}; }
        asm volatile("s_waitcnt lgkmcnt(0)" ::: "memory"); __builtin_amdgcn_s_barrier(); asm volatile("" ::: "memory");
        const size_t grow0 = (size_t)(tile >> 2) * 256; const int cw = wc * 32 + 8 * fq;
#pragma unroll
        for (int ai = 0; ai < 2; ++ai)
#pragma unroll
            for (int m = 0; m < 4; ++m) { const int lr = lr0 + ai * 128 + m * 16;
                const f32x4 pa = *(const LAS f32x4*)(P + lr * 4), pb = *(const LAS f32x4*)(P + lr * 4 + 2);
                const float S = (pa[0] + pa[2]) + (pb[0] + pb[2]), Q = (pa[1] + pa[3]) + (pb[1] + pb[3]);
                const float mu = S * (1.0f / RD), var = Q * (1.0f / RD) - mu * mu, r = 1.0f / sqrtf(fmaxf(var, 0.f) + GN_EPS);
                const size_t goff = (grow0 + lr) * 1024 + h * 256 + cw;
#pragma unroll
                for (int bj = 0; bj < 2; ++bj) { const u32x4 gw = *(const u32x4*)(rg + goff + bj * 128);
                    const f32x4 g0 = *(const f32x4*)(gn + h * 256 + bj * 128 + cw), g1 = *(const f32x4*)(gn + h * 256 + bj * 128 + cw + 4);
                    f32x4 o0, o1;
#pragma unroll
                    for (int e = 0; e < 4; ++e) { const float ga = (e & 1) ? bf_hi(gw[e >> 1]) : bf_lo(gw[e >> 1]), gb = (e & 1) ? bf_hi(gw[2 + (e >> 1)]) : bf_lo(gw[2 + (e >> 1)]);
                        o0[e] = silu_f(ga) * (acc[ai][bj][m][0][e] - mu) * (r * S_MIX8) * g0[e]; o1[e] = silu_f(gb) * (acc[ai][bj][m][1][e] - mu) * (r * S_MIX8) * g1[e]; }
                    u32x2 w; w.x = cvt_pk4_fp8(o0[0], o0[1], o0[2], o0[3]); w.y = cvt_pk4_fp8(o1[0], o1[1], o1[2], o1[3]);
                    *(u32x2*)(mix + (grow0 + lr) * DM + 1024 + h * 256 + bj * 128 + cw) = w; }
                asm volatile("" ::: "memory"); }
    }
};

struct MoeInfo { int toff[NE + 1]; };
__device__ __forceinline__ MoeInfo moe_info(const unsigned* ctl) {
    MoeInfo mi; int t = 0;
#pragma unroll
    for (int e = 0; e < NE; ++e) { mi.toff[e] = t; const int c = (int)__builtin_amdgcn_readfirstlane((int)ctl[CW_CNT + 64 * e]); t += (c + 255) >> 8; }
    mi.toff[NE] = t; return mi;
}
__device__ __forceinline__ int moe_expert(const MoeInfo& mi, int pm, int& lt) { int e = 0; lt = pm;
#pragma unroll
    for (int j = 1; j < NE; ++j) { const bool ge = pm >= mi.toff[j]; e += ge ? 1 : 0; lt = ge ? pm - mi.toff[j] : lt; }
    return e; }
struct SchedMoeUp {
    MoeInfo mi; const char* hb; const char* W; const int* list; int G, c;
    __device__ __forceinline__ bool next(int i, gm::Unit& u) const {
        int pm, pn; if (!gm::tile_order((long)i * G + c, mi.toff[NE], DFE / 128, pm, pn)) return false;
        int lt; const int e = moe_expert(mi, pm, lt);
        u.pm = pm; u.pn = pn; u.nt = DM / 128; u.aux = e; u.rows = list + e * NTOK + lt * 256;
        u.A = hb; u.B = W + ((size_t)e * (2 * DFE) + pn * 256) * DM; return true;
    }
};
struct EpiMoeUp {
    static constexpr bool PERM = true;
    unsigned char* H; const float* rfac; const int* list;
    __device__ __forceinline__ void operator()(const Acc& acc, const gm::Unit& u, int wr, int wc, int fr, int fq) const {
        const int lr0 = wr * 64 + fr, col0 = u.pn * 128 + wc * 32 + 8 * fq; const float* rf = rfac + (u.rows - list);
#pragma unroll
        for (int ai = 0; ai < 2; ++ai)
#pragma unroll
            for (int m = 0; m < 4; ++m) { const int lr = lr0 + ai * 128 + m * 16; const float r = rf[lr] * (1.0f / (S_HB8 * S_WUP8)); f32x4 o[2];
                const float ra = r * -LOG2E, c2 = r * r * S_H8;
#pragma unroll
                for (int n = 0; n < 2; ++n)
#pragma unroll
                    for (int e = 0; e < 4; ++e) { const float g = acc[ai][0][m][n][e], u = acc[ai][1][m][n][e]; o[n][e] = (g * u) * (c2 * __builtin_amdgcn_rcpf(1.0f + __builtin_amdgcn_exp2f(g * ra))); }
                u32x2 w; w.x = cvt_pk4_fp8c(o[0][0], o[0][1], o[0][2], o[0][3]); w.y = cvt_pk4_fp8c(o[1][0], o[1][1], o[1][2], o[1][3]);
                *(u32x2*)(H + (size_t)(u.pm * 256 + lr) * DFE + col0) = w; asm volatile("" ::: "memory"); }
    }
};
struct SchedMoeDown {
    MoeInfo mi; const char* H; const char* W; int G, c;
    __device__ __forceinline__ bool next(int i, gm::Unit& u) const {
        int pm, pn; if (!gm::tile_order((long)i * G + c, mi.toff[NE], DM / 256, pm, pn)) return false;
        int lt; const int e = moe_expert(mi, pm, lt);
        u.pm = pm; u.pn = pn; u.nt = DFE / 128; u.aux = e; u.rows = nullptr;
        u.A = H + (size_t)pm * 256 * DFE; u.B = W + ((size_t)e * DM + pn * 256) * DFE; return true;
    }
};
struct EpiMoeDown {
    static constexpr bool PERM = true;
    bf16_t* Y;
    __device__ __forceinline__ void operator()(const Acc& acc, const gm::Unit& u, int wr, int wc, int fr, int fq) const {
        const int row0 = u.pm * 256 + wr * 64 + fr, col0 = u.pn * 256 + wc * 32 + 8 * fq;
#pragma unroll
        for (int ai = 0; ai < 2; ++ai)
#pragma unroll
            for (int m = 0; m < 4; ++m) { bf16_t* rowp = Y + (size_t)(row0 + ai * 128 + m * 16) * DM + col0;
#pragma unroll
                for (int bj = 0; bj < 2; ++bj) *(u32x4*)(rowp + bj * 128) = pack8(acc[ai][bj][m][0] * (1.0f / (S_H8 * S_WDN8)), acc[ai][bj][m][1] * (1.0f / (S_H8 * S_WDN8))); }
    }
};

struct Args { const float* in[16]; float* out; unsigned char* ws; int ph_lo, ph_hi, use_bar, pad; };
typedef const __attribute__((address_space(4))) Args* KArgs;
__device__ __forceinline__ KArgs kargs() { KArgs p = (KArgs)__builtin_amdgcn_kernarg_segment_ptr(); asm volatile("" : "+s"(p)); return p; }
#define KIN(i) (as_global((const float*)kargs()->in[i]))
#define KOUT (as_global((float*)kargs()->out))
struct Ctx {
    LAS unsigned char* lds;
    unsigned char* ws; unsigned* ctl;
    int wave, G, gw, NGW, bx;
};


template <int OUT>
__device__ __forceinline__ void conv_item(const float* src0, const float* src1, int Nsrc, const float* gain, void* dstv, int Kdim, int mode, int d0, int k0, LAS float* scr, int lane, float wscale) {
    constexpr bool F8 = OUT == 1;
    const int d = d0 + lane; const float* src = src0; int col = d; bool valid = true;
    if (mode == 1) { if (d >= 2816) col = d - 176; else if (d >= 2560) valid = (d - 2560) < 80; }
    else if (mode == 2) { const int t = d >> 8, bj = (d >> 7) & 1, cc = d & 127; src = bj ? src1 : src0; col = 128 * t + cc; }
    const float* p = src + (size_t)k0 * Nsrc + col;
    float vv[64];
#pragma unroll
    for (int kk = 0; kk < 64; ++kk) vv[kk] = valid ? p[(size_t)kk * Nsrc] : 0.f;
    float qs = 1.f;
    if constexpr (OUT == 2) qs = wscale;
#pragma unroll
    for (int k16 = 0; k16 < 4; ++k16) {
#pragma unroll
        for (int k2 = 0; k2 < 16; ++k2) { const int kk = 16 * k16 + k2; float v = vv[kk]; if (gain) v *= gain[k0 + kk]; if (F8) v *= wscale; if (OUT == 2) v *= qs; scr[kk * 65 + lane] = v; }
        asm volatile("" ::: "memory"); }
    LDS_WAIT(); asm volatile("" ::: "memory");
    const int c = lane & 7;
#pragma unroll
    for (int j = 0; j < 8; ++j) { const int n = (lane >> 3) + 8 * j; const LAS float* s = scr + (8 * c) * 65 + n;
        if constexpr (OUT == 2) { u32x2 o; o.x = pk4_i8(s[0 * 65], s[1 * 65], s[2 * 65], s[3 * 65]); o.y = pk4_i8(s[4 * 65], s[5 * 65], s[6 * 65], s[7 * 65]);
            *(u32x2*)((unsigned char*)dstv + (size_t)(d0 + n) * Kdim + k0 + 8 * c) = o; }
        else if constexpr (F8) { u32x2 o; o.x = cvt_pk4_fp8c(s[0 * 65], s[1 * 65], s[2 * 65], s[3 * 65]); o.y = cvt_pk4_fp8c(s[4 * 65], s[5 * 65], s[6 * 65], s[7 * 65]);
            *(u32x2*)((unsigned char*)dstv + (size_t)(d0 + n) * Kdim + k0 + 8 * c) = o; }
        else { u32x4 o; o.x = cvt_pk_bf16(s[0 * 65], s[1 * 65]); o.y = cvt_pk_bf16(s[2 * 65], s[3 * 65]); o.z = cvt_pk_bf16(s[4 * 65], s[5 * 65]); o.w = cvt_pk_bf16(s[6 * 65], s[7 * 65]);
            *(u32x4*)((bf16_t*)dstv + (size_t)(d0 + n) * Kdim + k0 + 8 * c) = o; } }
    LDS_WAIT(); asm volatile("" ::: "memory");
}
template <int OUT = 0>
__device__ __forceinline__ void conv_job(int lane, int r, const float* s0, const float* s1, int Nsrc, const float* gain, void* dst, int Kdim, int Ndst, int mode, LAS float* scr, float wscale = 1.f) {
    const int ndb = Ndst / 64, kb = r / ndb, db = r % ndb;
    conv_item<OUT>(s0, s1, Nsrc, gain, dst, Kdim, mode, db * 64, kb * 64, scr, lane, wscale);
}
__device__ __forceinline__ float wmax_item(const float* src0, const float* src1, int Nsrc, const float* gain, int mode, int d0, int k0, int lane) {
    const int d = d0 + lane; const float* src = src0; int col = d; bool valid = true;
    if (mode == 1) { if (d >= 2816) col = d - 176; else if (d >= 2560) valid = (d - 2560) < 80; }
    else if (mode == 2) { const int t = d >> 8, bj = (d >> 7) & 1, cc = d & 127; src = bj ? src1 : src0; col = 128 * t + cc; }
    const float* p = src + (size_t)k0 * Nsrc + col; float mx = 0.f;
    if (valid) {
#pragma unroll 1
        for (int k64 = 0; k64 < 256; k64 += 64) { float t[64];
#pragma unroll
            for (int kk = 0; kk < 64; ++kk) t[kk] = p[(size_t)(k64 + kk) * Nsrc];
#pragma unroll
            for (int k16 = 0; k16 < 4; ++k16) {
#pragma unroll
                for (int k2 = 0; k2 < 16; ++k2) mx = fmaxf(mx, fabsf(t[16 * k16 + k2] * gain[k0 + k64 + 16 * k16 + k2]));
                asm volatile("" ::: "memory"); } } }
#pragma unroll
    for (int o2 = 1; o2 < 64; o2 <<= 1) mx = fmaxf(mx, __shfl_xor(mx, o2));
    return mx;
}
template <int KIND>
__device__ __forceinline__ void i8_tile(Ctx& C, int t, unsigned char* wsl, LAS float* scr, int lane) {
    constexpr int Nsrc = KIND == 0 ? INW : DFF, mode = KIND == 0 ? 1 : 2;
    const int l = KIND == 0 ? t / (INP / 256) : 0, pn = KIND == 0 ? t % (INP / 256) : t;
    const float* s0 = KIND == 0 ? KIN(3) + (size_t)l * DM * INW : KIN(9); const float* s1 = KIND == 0 ? nullptr : KIN(10); const float* gain = KIND == 0 ? KIN(2) + l * DM : KIN(8);
    unsigned char* dst = KIND == 0 ? (unsigned char*)(wsl + WS_W_IN) + (size_t)l * INP * DM : (unsigned char*)(wsl + WS_W_FUP);
    float* sb = KIND == 0 ? (float*)(wsl + WS_SMALL + SM_SBIN) + l * (INP / 256) + pn : (float*)(wsl + WS_SMALL + SM_SBF) + pn;
    LAS float* red = (LAS float*)(C.lds + 8 * 16896);
    float mx = 0.f;
#pragma unroll 1
    for (int cg = 0; cg < 4; ++cg) mx = fmaxf(mx, wmax_item(s0, s1, Nsrc, gain, mode, pn * 256 + cg * 64, C.wave * 256, lane));
    if (lane == 0) red[C.wave] = mx;
    __syncthreads();
    float tm = 0.f;
#pragma unroll
    for (int w = 0; w < 8; ++w) tm = fmaxf(tm, red[w]);
    const float qs = tm > 0.f ? 127.0f / tm : 0.f;
    if (C.wave == 0 && lane == 0) *sb = tm * (1.0f / 127.0f);
#pragma unroll 1
    for (int it = C.wave; it < 4 * (DM / 64); it += 8) { const int cg = it & 3, kb = it >> 2;
        conv_item<2>(s0, s1, Nsrc, gain, dst, DM, mode, pn * 256 + cg * 64, kb * 64, scr, lane, qs); }
    __syncthreads();
}
__device__ __forceinline__ void phase_prepA(Ctx& C) {
    const int tidl = tid_l(), lane = tidl & 63; (void)lane;
    unsigned char* const wsl = launder(C.ws); unsigned* const ctll = (unsigned*)(wsl + WS_CTL);
    LAS float* scr = (LAS float*)(C.lds + C.wave * 16896);
    constexpr int I_OUT = (DM / 64) * (DM / 64), I_FDN = (DM / 64) * (DFF / 64), I_MUP = (2 * DFE / 64) * (DM / 64), I_MDN = (DM / 64) * (DFE / 64);
    constexpr int NTILE8 = 2 * (INP / 256) + 2 * DFF / 256;
    for (int t = C.bx; t < NTILE8; t += C.G) { if (t < 2 * (INP / 256)) i8_tile<0>(C, t, wsl, scr, lane); else i8_tile<1>(C, t - 2 * (INP / 256), wsl, scr, lane); }
    for (int r = C.gw; r < 2 * I_OUT; r += C.NGW) { const int l = r / I_OUT;
        conv_job<1>(lane, r - l * I_OUT, KIN(7) + (size_t)l * DM * DM, nullptr, DM, nullptr, (unsigned char*)(wsl + WS_W_OUT) + (size_t)l * DM * DM, DM, DM, 0, scr, S_WOUT8); }
    for (int r = C.gw; r < I_FDN; r += C.NGW) conv_job<1>(lane, r, KIN(11), nullptr, DM, nullptr, (unsigned char*)(wsl + WS_W_FDN), DFF, DM, 0, scr, S_WDN8);
    for (;;) { int itb = 0; if (lane == 0) itb = (int)atomicAdd(ctll + CW_QUEUE, 8u); itb = __builtin_amdgcn_readfirstlane(itb);
        if (itb >= NE * I_MUP + NE * I_MDN) break;
#pragma unroll 1
      for (int it = itb; it < itb + 8 && it < NE * I_MUP + NE * I_MDN; ++it) {
        if (it < NE * I_MUP) { const int e = it / I_MUP;
            conv_job<1>(lane, it - e * I_MUP, KIN(13) + (size_t)e * DM * DFE, KIN(14) + (size_t)e * DM * DFE, DFE, KIN(8) + DM, (unsigned char*)(wsl + WS_W_MUP) + (size_t)e * 2 * DFE * DM, DM, 2 * DFE, 2, scr, S_WUP8); }
        else { const int r = it - NE * I_MUP, e = r / I_MDN;
            conv_job<1>(lane, r - e * I_MDN, KIN(15) + (size_t)e * DFE * DM, nullptr, DM, nullptr, (unsigned char*)(wsl + WS_W_MDN) + (size_t)e * DM * DFE, DFE, DM, 0, scr, S_WDN8); } } }
    float* rc = (float*)(wsl + WS_ROPE); float* rsn = rc + SEQ * 128;
    for (int i = C.gw * 64 + lane; i < SEQ * 128; i += C.NGW * 64) { const int pos = i >> 7, j = i & 127;
        const float inv = (float)pow(10000.0, -(double)j / 128.0); const float ang = (float)pos * inv; double sn, cs; sincos((double)ang, &sn, &cs); rc[i] = (float)cs; rsn[i] = (float)sn; }
    int* list = (int*)(wsl + WS_SMALL + SM_LIST);
    float* rfac = (float*)(wsl + WS_SMALL + SM_RFAC);
    for (int i = C.gw * 64 + lane; i < NE * NTOK; i += C.NGW * 64) { list[i] = 0; rfac[i] = 0.f; }
}

template <bool ROUTER>
__device__ __forceinline__ void phase_stats(Ctx& C, const float* h, int layer) {
    const int tidl = tid_l(), lane = tidl & 63; (void)lane;
    unsigned char* const wsl = launder(C.ws); unsigned* const ctll = (unsigned*)(wsl + WS_CTL); (void)ctll;
    bf16_t* hb = (bf16_t*)(wsl + WS_HB); float* rstd = (float*)(wsl + WS_SMALL + SM_RSTD);
    const float* gain = KIN(8) + layer * DM; const float* wr = KIN(12);
    for (int row = C.gw; row < NTOK; row += C.NGW) {
        f32x4 v[8]; float ss = 0.f;
#pragma unroll
        for (int j = 0; j < 8; ++j) {
            if constexpr (ROUTER) { const u32x2 w = ((const u32x2*)(hb + (size_t)row * DM) + lane)[64 * j]; v[j] = (f32x4){bf_lo(w.x), bf_hi(w.x), bf_lo(w.y), bf_hi(w.y)}; }
            else v[j] = ((const f32x4*)(h + (size_t)row * DM) + lane)[64 * j];
            ss += (v[j][0] * v[j][0] + v[j][1] * v[j][1]) + (v[j][2] * v[j][2] + v[j][3] * v[j][3]); }
        ss = wave_sum(ss); const float r = 1.0f / sqrtf(ss * (1.0f / DM) + EPS);
        if (lane == 0) rstd[row] = r;
        if constexpr (!ROUTER) {
            float mx = 0.f;
#pragma unroll
            for (int j = 0; j < 8; ++j) mx = fmaxf(fmaxf(mx, fmaxf(fabsf(v[j][0]), fabsf(v[j][1]))), fmaxf(fabsf(v[j][2]), fabsf(v[j][3])));
#pragma unroll
            for (int o2 = 1; o2 < 64; o2 <<= 1) mx = fmaxf(mx, __shfl_xor(mx, o2));
            const float q = mx > 0.f ? 127.0f / mx : 0.f;
            if (lane == 0) ((float*)(wsl + WS_SMALL + SM_SA))[row] = mx * (1.0f / 127.0f);
            unsigned* o8 = (unsigned*)(wsl + WS_HB8 + (size_t)row * DM) + lane;
#pragma unroll
            for (int j = 0; j < 8; ++j) o8[64 * j] = pk4_i8(v[j][0] * q, v[j][1] * q, v[j][2] * q, v[j][3] * q);
        } else {
            unsigned* o8 = (unsigned*)(wsl + WS_HB8 + (size_t)row * DM) + lane;
#pragma unroll
            for (int j = 0; j < 8; ++j) o8[64 * j] = cvt_pk4_fp8c(v[j][0] * S_HB8, v[j][1] * S_HB8, v[j][2] * S_HB8, v[j][3] * S_HB8);
        }
        if constexpr (ROUTER) {
            float lg[NE];
#pragma unroll
            for (int e = 0; e < NE; ++e) lg[e] = 0.f;
#pragma unroll
            for (int j = 0; j < 8; ++j) { const int k0 = 4 * lane + 256 * j; const f32x4 g4 = *(const f32x4*)(gain + k0);
#pragma unroll
                for (int q = 0; q < 4; ++q) { const float x = v[j][q] * g4[q]; const f32x4 w0 = *(const f32x4*)(wr + (size_t)(k0 + q) * NE), w1 = *(const f32x4*)(wr + (size_t)(k0 + q) * NE + 4);
                    lg[0] += x * w0[0]; lg[1] += x * w0[1]; lg[2] += x * w0[2]; lg[3] += x * w0[3]; lg[4] += x * w1[0]; lg[5] += x * w1[1]; lg[6] += x * w1[2]; lg[7] += x * w1[3]; } }
#pragma unroll
            for (int e = 0; e < NE; ++e) lg[e] = wave_sum(lg[e]) * r;
            int i1 = 0; float v1 = lg[0];
#pragma unroll
            for (int e = 1; e < NE; ++e) if (lg[e] > v1) { v1 = lg[e]; i1 = e; }
            int i2 = -1; float v2 = -3.0e38f;
#pragma unroll
            for (int e = 0; e < NE; ++e) if (e != i1 && lg[e] > v2) { v2 = lg[e]; i2 = e; }
            const float g1 = 1.0f / (1.0f + __expf(v2 - v1)), g2 = 1.0f - g1;
            if (lane == 0) {
                const int s1 = (int)atomicAdd(ctll + CW_CNT + 64 * i1, 1u), s2 = (int)atomicAdd(ctll + CW_CNT + 64 * i2, 1u);
                int* list = (int*)(wsl + WS_SMALL + SM_LIST); list[i1 * NTOK + s1] = row; list[i2 * NTOK + s2] = row;
                float* rfac = (float*)(wsl + WS_SMALL + SM_RFAC); rfac[i1 * NTOK + s1] = r; rfac[i2 * NTOK + s2] = r;
                int* te = (int*)(wsl + WS_SMALL + SM_TOKE); int* ts = (int*)(wsl + WS_SMALL + SM_TOKS); float* tg = (float*)(wsl + WS_SMALL + SM_TOKG);
                te[2 * row] = i1; te[2 * row + 1] = i2; ts[2 * row] = s1; ts[2 * row + 1] = s2; tg[2 * row] = g1; tg[2 * row + 1] = g2;
            }
        }
    }
}

__device__ __forceinline__ void phase_rstd(Ctx& C) {
    const int tidl = tid_l(), lane = tidl & 63;
    unsigned char* const wsl = launder(C.ws);
    const bf16_t* hb = (const bf16_t*)(wsl + WS_HB); float* rstd = (float*)(wsl + WS_SMALL + SM_RSTD); float* sa = (float*)(wsl + WS_SMALL + SM_SA);
    for (int row = C.gw; row < NTOK; row += C.NGW) {
        const u32x4* p = (const u32x4*)(hb + (size_t)row * DM) + lane; float ss = 0.f, mx = 0.f; u32x4 w[4];
#pragma unroll
        for (int j = 0; j < 4; ++j) { w[j] = p[64 * j];
#pragma unroll
            for (int q = 0; q < 4; ++q) { const float a = bf_lo(w[j][q]), b = bf_hi(w[j][q]); ss += a * a + b * b; mx = fmaxf(mx, fmaxf(fabsf(a), fabsf(b))); } }
        ss = wave_sum(ss);
#pragma unroll
        for (int o2 = 1; o2 < 64; o2 <<= 1) mx = fmaxf(mx, __shfl_xor(mx, o2));
        const float qq = mx > 0.f ? 127.0f / mx : 0.f;
        if (lane == 0) { rstd[row] = 1.0f / sqrtf(ss * (1.0f / DM) + EPS); sa[row] = mx * (1.0f / 127.0f); }
        u32x2* o8 = (u32x2*)(wsl + WS_HB8 + (size_t)row * DM) + lane;
#pragma unroll
        for (int j = 0; j < 4; ++j) { u32x2 o; o.x = pk4_i8(bf_lo(w[j][0]) * qq, bf_hi(w[j][0]) * qq, bf_lo(w[j][1]) * qq, bf_hi(w[j][1]) * qq);
            o.y = pk4_i8(bf_lo(w[j][2]) * qq, bf_hi(w[j][2]) * qq, bf_lo(w[j][3]) * qq, bf_hi(w[j][3]) * qq); o8[64 * j] = o; }
    }
}

__device__ __forceinline__ void phase_post(Ctx& C, int layer) {
    const int tidl = tid_l(), lane = tidl & 63; (void)lane;
    unsigned char* const wsl = launder(C.ws); unsigned* const ctll = (unsigned*)(wsl + WS_CTL); (void)ctll;
    bf16_t* q = (bf16_t*)(wsl + WS_PROJ + PJ_Q); bf16_t* k = (bf16_t*)(wsl + WS_PROJ + PJ_K);
    const float* qg = KIN(4) + layer * AD; const float* kg = KIN(5) + layer * AD;
    const float qsc = 0.088388347648318440f * LOG2E;
    const f32x2 qg2 = *(const f32x2*)(qg + 2 * lane), kg2 = *(const f32x2*)(kg + 2 * lane);
    for (int row0 = C.gw; row0 < NTOK; row0 += 4 * C.NGW) {
        unsigned w[4][10];
#pragma unroll
        for (int j = 0; j < 4; ++j) { const int row = row0 + j * C.NGW; if (row < NTOK) { const unsigned* qr = (const unsigned*)(q + (size_t)row * 1024) + lane; const unsigned* kr = (const unsigned*)(k + (size_t)row * 256) + lane;
#pragma unroll
            for (int hh = 0; hh < 8; ++hh) w[j][hh] = qr[64 * hh];
            w[j][8] = kr[0]; w[j][9] = kr[64]; } }
#pragma unroll
        for (int j = 0; j < 4; ++j) { const int row = row0 + j * C.NGW; if (row < NTOK) { unsigned* qr = (unsigned*)(q + (size_t)row * 1024) + lane; unsigned* kr = (unsigned*)(k + (size_t)row * 256) + lane;
#pragma unroll
            for (int hh = 0; hh < 10; ++hh) { const float a = bf_lo(w[j][hh]), b = bf_hi(w[j][hh]); const float ss = wave_sum(a * a + b * b); const float r = 1.0f / sqrtf(ss * (1.0f / AD) + EPS);
                if (hh < 8) qr[64 * hh] = cvt_pk_bf16(a * r * qg2[0] * qsc, b * r * qg2[1] * qsc); else kr[64 * (hh - 8)] = cvt_pk_bf16(a * r * kg2[0], b * r * kg2[1]); } } }
    }
}

__device__ __forceinline__ void phase_retscan(Ctx& C) {
    const int tidl = tid_l(), lane = tidl & 63;
    unsigned char* const wsl = launder(C.ws);
    const float* KVT = (const float*)(wsl + WS_PROJ + PJ_KVT); bf16_t* SV = (bf16_t*)(wsl + WS_PROJ + PJ_SV);
    for (int idx = C.gw * 64 + lane; idx < 16 * 256 * 64; idx += C.NGW * 64) {
        const int bh = idx >> 14, e = (idx >> 6) & 255, d4 = idx & 63, b = bh >> 2, h = bh & 3;
        const float g256 = __builtin_amdgcn_exp2f(256.0f * __builtin_log2f(1.0f - __builtin_exp2f(-5.0f - (float)h)));
        f32x4 S = {0.f, 0.f, 0.f, 0.f};
#pragma unroll 4
        for (int n = 0; n < 16; ++n) { const size_t tile = (size_t)(b * 16 + n) * 4 + h;
            u32x2 w; w.x = cvt_pk_bf16(S[0], S[1]); w.y = cvt_pk_bf16(S[2], S[3]);
            *(u32x2*)(SV + (tile * 256 + e) * 512 + 4 * d4) = w;
            if (n < 15) { const f32x4 kv = *(const f32x4*)(KVT + tile * 65536 + (size_t)e * 256 + 4 * d4); S = S * g256 + kv; } }
    }
}

__device__ __forceinline__ void phase_combine(Ctx& C) {
    const int tidl = tid_l(), lane = tidl & 63; (void)lane;
    unsigned char* const wsl = launder(C.ws); unsigned* const ctll = (unsigned*)(wsl + WS_CTL); (void)ctll;
    const MoeInfo mi = moe_info(ctll);
    const bf16_t* Y = (const bf16_t*)(wsl + WS_PROJ + PJ_Y); const bf16_t* hbp = (const bf16_t*)(wsl + WS_HB);
    const int* te = (const int*)(wsl + WS_SMALL + SM_TOKE); const int* ts = (const int*)(wsl + WS_SMALL + SM_TOKS); const float* tg = (const float*)(wsl + WS_SMALL + SM_TOKG);
    for (int row = C.gw; row < NTOK; row += C.NGW) {
        const int e1 = te[2 * row], e2 = te[2 * row + 1]; const float g1 = tg[2 * row], g2 = tg[2 * row + 1];
        int t1 = 0, t2 = 0;
#pragma unroll
        for (int e = 0; e < NE; ++e) { t1 = (e == e1) ? mi.toff[e] : t1; t2 = (e == e2) ? mi.toff[e] : t2; }
        const size_t p1 = (size_t)t1 * 256 + ts[2 * row], p2 = (size_t)t2 * 256 + ts[2 * row + 1];
#pragma unroll
        for (int j = 0; j < 4; ++j) { const int c = 8 * lane + 512 * j;
            const u32x4 a = *(const u32x4*)(Y + p1 * DM + c), b = *(const u32x4*)(Y + p2 * DM + c);
            float* op = KOUT + (size_t)row * DM + c; const u32x4 hw = *(const u32x4*)(hbp + (size_t)row * DM + c);
            f32x4 o0 = {bf_lo(hw.x), bf_hi(hw.x), bf_lo(hw.y), bf_hi(hw.y)}, o1 = {bf_lo(hw.z), bf_hi(hw.z), bf_lo(hw.w), bf_hi(hw.w)};
            o0[0] += g1 * bf_lo(a.x) + g2 * bf_lo(b.x); o0[1] += g1 * bf_hi(a.x) + g2 * bf_hi(b.x); o0[2] += g1 * bf_lo(a.y) + g2 * bf_lo(b.y); o0[3] += g1 * bf_hi(a.y) + g2 * bf_hi(b.y);
            o1[0] += g1 * bf_lo(a.z) + g2 * bf_lo(b.z); o1[1] += g1 * bf_hi(a.z) + g2 * bf_hi(b.z); o1[2] += g1 * bf_lo(a.w) + g2 * bf_lo(b.w); o1[3] += g1 * bf_hi(a.w) + g2 * bf_hi(b.w);
            *(f32x4*)op = o0; *(f32x4*)(op + 4) = o1; }
    }
}

__device__ __forceinline__ void phase_scores(Ctx& C) {
    const int tidl = tid_l(), lane = tidl & 63; (void)lane;
    unsigned char* const wsl = launder(C.ws); unsigned* const ctll = (unsigned*)(wsl + WS_CTL); (void)ctll;
    const bf16_t* iq = (const bf16_t*)(wsl + WS_PROJ + PJ_IQ); const bf16_t* ik = (const bf16_t*)(wsl + WS_PROJ + PJ_IK);
    const float* iw = (const float*)(wsl + WS_PROJ + PJ_IW); float* sc = (float*)(wsl + WS_BIG);
    const int r = lane & 31, hi = lane >> 5;
    for (int U = C.bx; U < NBATCH * 288; U += C.G) {
        int b, n, g;
        { const int rnd = U / C.G, cc = U - rnd * C.G; const int k = (C.G == 256) ? rnd * 256 + ((rnd & 1) ? 255 - cc : cc) : U;
          if (k < 928) { b = k & 3; const int kk = k >> 2; int j = 1; while (4 * (j + 1) * j <= kk) ++j; const int r_ = kk - 4 * j * (j - 1); n = 8 * j + r_ / j - 1; g = r_ % j; }
          else { const int idx = k - 928, sz = 7 - (idx >> 5), t = (idx >> 2) & 7; b = idx & 3; n = 8 * t + sz - 1; g = t; } }
        const int t0 = b * SEQ + 64 * n + 8 * C.wave;
        bf16x8 Af[4][4]; f32x4 wv[4][4];
#pragma unroll
        for (int blk = 0; blk < 4; ++blk) { const int qi = 2 * blk + ((r >> 2) & 1), head = 4 * (r >> 3) + (r & 3);
            const bf16_t* p = iq + (size_t)(t0 + qi) * 1024 + head * 64 + 8 * hi;
#pragma unroll
            for (int ks = 0; ks < 4; ++ks) Af[blk][ks] = *(const bf16x8*)(p + 16 * ks);
            const float* wp = iw + (size_t)(t0 + 2 * blk + hi) * 16;
#pragma unroll
            for (int i = 0; i < 4; ++i) wv[blk][i] = *(const f32x4*)(wp + 4 * i); }
        const int kt1 = (8 * g + 8 < n + 1) ? 8 * g + 8 : n + 1, ntile = kt1 - 8 * g;
        __syncthreads();
        { const unsigned char* src = (const unsigned char*)(ik + (size_t)(b * SEQ + 512 * g) * 64);
          for (int off = tidl * 16; off < ntile * 8192; off += 512 * 16) { const int row = off >> 7, ch = (off >> 4) & 7;
              *(LAS u32x4*)(C.lds + row * 128 + ((ch ^ ((row >> 1) & 7)) << 4)) = *(const u32x4*)(src + off); } }
        __syncthreads();
#define SC_TILE(kt) do { bf16x8 Bf[2][4]; \
            _Pragma("unroll") for (int kb = 0; kb < 2; ++kb) { const int row_ = 64 * ((kt) - 8 * g) + 32 * kb + r; \
                _Pragma("unroll") for (int ks = 0; ks < 4; ++ks) Bf[kb][ks] = *(const LAS bf16x8*)(C.lds + row_ * 128 + (((2 * ks + hi) ^ ((row_ >> 1) & 7)) << 4)); } \
            _Pragma("unroll") for (int blk = 0; blk < 4; ++blk) { f32x16 a0 = {}, a1 = {}; \
            _Pragma("unroll") for (int ks = 0; ks < 4; ++ks) { a0 = __builtin_amdgcn_mfma_f32_32x32x16_bf16(Af[blk][ks], Bf[0][ks], a0, 0, 0, 0); a1 = __builtin_amdgcn_mfma_f32_32x32x16_bf16(Af[blk][ks], Bf[1][ks], a1, 0, 0, 0); } \
            float s0 = 0.f, s1 = 0.f; \
            _Pragma("unroll") for (int i = 0; i < 16; ++i) { s0 += wv[blk][i >> 2][i & 3] * __builtin_amdgcn_fmed3f(a0[i], 0.f, 3.0e38f); s1 += wv[blk][i >> 2][i & 3] * __builtin_amdgcn_fmed3f(a1[i], 0.f, 3.0e38f); }     \
            float* o_ = sc + (size_t)(t0 + 2 * blk + hi) * SEQ + 64 * (kt) + r; o_[0] = s0; o_[32] = s1; } } while (0)
        for (int kt = 8 * g; kt < kt1; ++kt) SC_TILE(kt);
#undef SC_TILE
    }
}

__device__ __forceinline__ void phase_select(Ctx& C) {
    const int tidl = tid_l(), lane = tidl & 63;
    unsigned char* const wsl = launder(C.ws);
    const float* sc = (const float*)(wsl + WS_BIG); unsigned long long* mask = (unsigned long long*)(wsl + WS_MASK);
    LAS unsigned* hist = (LAS unsigned*)(C.lds + C.wave * 16384);
    for (int row = C.gw; row < NTOK; row += C.NGW) {
        const int n = (row & (SEQ - 1)) >> 6;
        unsigned wlo, whi;
        if (n < 4) { wlo = (lane <= n) ? 0xffffffffu : 0u; whi = wlo; }
        else {
            const bool act = lane <= n;
            float key[64];
            { const f32x4* sr = (const f32x4*)(sc + (size_t)row * SEQ + 64 * lane);
#pragma unroll
              for (int i = 0; i < 16; ++i) { f32x4 v = {0.f, 0.f, 0.f, 0.f}; if (act) v = sr[i]; key[4 * i] = v[0]; key[4 * i + 1] = v[1]; key[4 * i + 2] = v[2]; key[4 * i + 3] = v[3]; } }
            float mn = 3.0e38f, mx = -3.0e38f;
#pragma unroll
            for (int j = 0; j < 64; ++j) { mn = fminf(mn, key[j]); mx = fmaxf(mx, key[j]); }
            if (!act) { mn = 3.0e38f; mx = -3.0e38f; }
#pragma unroll
            for (int o = 1; o < 64; o <<= 1) { mn = fminf(mn, __shfl_xor(mn, o)); mx = fmaxf(mx, __shfl_xor(mx, o)); }
            const float rng = mx - mn, scale = rng > 0.f ? 4095.5f / rng : 0.f;
            { const u32x4 z = {0u, 0u, 0u, 0u};
#pragma unroll
              for (int i = 0; i < 16; ++i) *(LAS u32x4*)(hist + 4 * (lane + 64 * i)) = z; }
            LDS_WAIT();
            int bin[64];
#pragma unroll
            for (int j = 0; j < 64; ++j) { int bq = (int)((key[j] - mn) * scale); bq = bq > 4095 ? 4095 : bq; bin[j] = bq; }
            if (act) {
#pragma unroll
                for (int j = 0; j < 64; ++j) __hip_atomic_fetch_add(hist + bin[j], 1u, __ATOMIC_RELAXED, __HIP_MEMORY_SCOPE_WORKGROUP);
            }
            LDS_WAIT(); asm volatile("" ::: "memory");
            unsigned h[64]; unsigned cl = 0u;
#pragma unroll
            for (int i = 0; i < 16; ++i) { const u32x4 v = *(const LAS u32x4*)(hist + 64 * lane + 4 * i); h[4 * i] = v[0]; h[4 * i + 1] = v[1]; h[4 * i + 2] = v[2]; h[4 * i + 3] = v[3]; cl += (v[0] + v[1]) + (v[2] + v[3]); }
            unsigned suf = cl;
#pragma unroll
            for (int o = 1; o < 64; o <<= 1) { const unsigned t = __shfl_down(suf, o); if (lane + o < 64) suf += t; }
            const unsigned above = suf - cl;
            unsigned run = above; int bsel = -1; unsigned cab = 0u;
#pragma unroll
            for (int i = 63; i >= 0; --i) { const unsigned prev = run; run += h[i]; if (run >= 256u && prev < 256u) { bsel = i; cab = prev; } }
            const unsigned long long ff = __ballot(bsel >= 0);
            const int Ls = __builtin_ctzll(ff);
            const int B = __shfl(64 * lane + bsel, Ls); const int chi = (int)__shfl(cab, Ls);
            int need = 256 - chi;
            unsigned hlo = 0u, hhi = 0u, clo = 0u, chh = 0u;
#pragma unroll
            for (int j = 0; j < 32; ++j) { hlo |= (bin[j] > B) ? (1u << j) : 0u; clo |= (bin[j] == B) ? (1u << j) : 0u; hhi |= (bin[32 + j] > B) ? (1u << j) : 0u; chh |= (bin[32 + j] == B) ? (1u << j) : 0u; }
            if (!act) { hlo = 0u; hhi = 0u; clo = 0u; chh = 0u; }
            int m = __builtin_popcount(clo) + __builtin_popcount(chh);
#pragma unroll
            for (int o = 1; o < 64; o <<= 1) m += __shfl_xor(m, o);
            unsigned slo = clo, shi = chh;
            if (m != need) {
                slo = 0u; shi = 0u;
                for (int it = 0; it < need; ++it) {
                    float bk = -3.0e38f; int bj = 64;
#pragma unroll
                    for (int j = 0; j < 64; ++j) { const unsigned cb = j < 32 ? (clo & ~slo) : (chh & ~shi); const bool c = ((cb >> (j & 31)) & 1u) && (key[j] > bk); bk = c ? key[j] : bk; bj = c ? j : bj; }
                    float wm = bk;
#pragma unroll
                    for (int o = 1; o < 64; o <<= 1) wm = fmaxf(wm, __shfl_xor(wm, o));
                    const unsigned long long wf = __ballot(bj < 64 && bk == wm);
                    const int wl = __builtin_ctzll(wf);
                    if (lane == wl) { if (bj < 32) slo |= 1u << bj; else shi |= 1u << (bj - 32); }
                }
            }
            wlo = hlo | slo; whi = hhi | shi;
        }
        mask[(size_t)row * 64 + lane] = ((unsigned long long)whi << 32) | wlo;
    }
}

namespace at {
constexpr int D = 128, KVBLK = 64;
constexpr int SHM_V = KVBLK * D * 2, SHM_K = KVBLK * D * 2;
constexpr int NBUF = 3;
constexpr int OFF_WS = NBUF * SHM_V + NBUF * SHM_K, OFF_BIAS = OFF_WS + 8 * 64 * 4, LDS_BYTES = OFF_BIAS + 4 * 160 * 4;
constexpr float THR2 = 11.5f;
#define KSWZ(row, colB) ((row) * 256 + ((colB) ^ (((row) & 7) << 4)))
#define SBAR() __builtin_amdgcn_sched_barrier(0)
__device__ __forceinline__ int crow(int r, int hi) { return (r & 3) + 8 * (r >> 2) + 4 * hi; }
__device__ __forceinline__ void partialSM(f32x16& p0, f32x16& p1, float& m_reg, float& mn, float& alpha) {
    float pmax = p0[0];
#pragma unroll
    for (int r = 1; r < 16; ++r) pmax = fmaxf(pmax, p0[r]);
#pragma unroll
    for (int r = 0; r < 16; ++r) pmax = fmaxf(pmax, p1[r]);
    { auto rr = __builtin_amdgcn_permlane32_swap(__float_as_uint(pmax), __float_as_uint(pmax), false, false);
      pmax = fmaxf(__uint_as_float(rr[0]), __uint_as_float(rr[1])); }
    { const bool keep = __all(pmax - m_reg <= THR2);
      const float mcand = fmaxf(m_reg, pmax); mn = keep ? m_reg : mcand; alpha = keep ? 1.f : __builtin_amdgcn_exp2f(m_reg - mcand); m_reg = mn; }
    { const f32x2 mn2 = {mn, mn};
#pragma unroll
      for (int r = 0; r < 8; ++r) { f32x2 t = {p0[2 * r], p0[2 * r + 1]}; t = t - mn2; p0[2 * r] = t[0]; p0[2 * r + 1] = t[1]; }
#pragma unroll
      for (int r = 0; r < 8; ++r) { f32x2 t = {p1[2 * r], p1[2 * r + 1]}; t = t - mn2; p1[2 * r] = t[0]; p1[2 * r + 1] = t[1]; } }
#pragma unroll
    for (int r = 0; r < 16; ++r) p0[r] = __builtin_amdgcn_exp2f(p0[r]);
}
__device__ __forceinline__ void finishSM(f32x16& p0, f32x16& p1, float alpha, float& l_reg, bf16x8& pa0, bf16x8& pa1, bf16x8& pa2, bf16x8& pa3) {
#pragma unroll
    for (int r = 0; r < 16; ++r) p1[r] = __builtin_amdgcn_exp2f(p1[r]);
    f32x2 ps2 = {0.f, 0.f};
#pragma unroll
    for (int r = 0; r < 8; ++r) ps2 = ps2 + (f32x2){p0[2 * r], p0[2 * r + 1]};
#pragma unroll
    for (int r = 0; r < 8; ++r) ps2 = ps2 + (f32x2){p1[2 * r], p1[2 * r + 1]};
    float ps = ps2[0] + ps2[1];
    { auto rr = __builtin_amdgcn_permlane32_swap(__float_as_uint(ps), __float_as_uint(ps), false, false);
      ps = __uint_as_float(rr[0]) + __uint_as_float(rr[1]); }
    l_reg = l_reg * alpha + ps;
#define PK4(P, BASE, OUT) do { unsigned a0 = cvt_pk_bf16(P[BASE + 0], P[BASE + 1]), a1 = cvt_pk_bf16(P[BASE + 2], P[BASE + 3]);   \
    unsigned b0 = cvt_pk_bf16(P[BASE + 4], P[BASE + 5]), b1 = cvt_pk_bf16(P[BASE + 6], P[BASE + 7]);                              \
    auto r0 = __builtin_amdgcn_permlane32_swap(a0, b0, false, false); auto r1 = __builtin_amdgcn_permlane32_swap(a1, b1, false, false); \
    u32x4 w = {r0[0], r1[0], r0[1], r1[1]}; OUT = *reinterpret_cast<bf16x8*>(&w); } while (0)
    PK4(p0, 0, pa0); PK4(p0, 8, pa1); PK4(p1, 0, pa2); PK4(p1, 8, pa3);
#undef PK4
}
__device__ __forceinline__ void qkt(f32x16& p0, f32x16& p1, const LAS char* Ks, const bf16x8* qr, int r32, int hi) {
    p0 = f32x16{}; p1 = f32x16{};
#pragma unroll
    for (int d0 = 0; d0 < 8; ++d0) { const int cb = (d0 * 16 + hi * 8) * 2;
        const bf16x8 b0 = *(const LAS bf16x8*)(Ks + KSWZ(r32, cb));
        const bf16x8 b1 = *(const LAS bf16x8*)(Ks + KSWZ(32 + r32, cb));
        p0 = __builtin_amdgcn_mfma_f32_32x32x16_bf16(b0, qr[d0], p0, 0, 0, 0);
        p1 = __builtin_amdgcn_mfma_f32_32x32x16_bf16(b1, qr[d0], p1, 0, 0, 0); }
}
__device__ __forceinline__ int v_st(int k, int c) { const int kk = (k & ~0xC) | ((k & 4) << 1) | ((k & 8) >> 1); return ((kk >> 3) * 4 + (c >> 5)) * 512 + ((kk & 7) * 32 + (c & 31)) * 2; }
__device__ __forceinline__ int v_rd_base(int lane) { return ((lane & 3) << 3) | (((lane >> 2) & 3) << 6) | (((lane >> 4) & 1) << 5) | (((lane >> 5) & 1) << 8); }
constexpr int v_rd_off(int d0, int ks, int half) { return d0 * 512 + ks * 4096 + half * 2048; }
template <int OFF> __device__ __forceinline__ s16x4 tr_read(const LAS char* vb) { return __builtin_amdgcn_ds_read_tr16_b64_v4i16((LAS s16x4*)(vb + OFF)); }
template <int KS> __device__ __forceinline__ void pv_step(f32x16* o, const LAS char* vb, bf16x8 pa) {
#define PK(L, H) (bf16x8){L[0], L[1], L[2], L[3], H[0], H[1], H[2], H[3]}
    { const s16x4 l = tr_read<v_rd_off(0, KS, 0)>(vb), h = tr_read<v_rd_off(0, KS, 1)>(vb); o[0] = __builtin_amdgcn_mfma_f32_32x32x16_bf16(pa, PK(l, h), o[0], 0, 0, 0); }
    { const s16x4 l = tr_read<v_rd_off(1, KS, 0)>(vb), h = tr_read<v_rd_off(1, KS, 1)>(vb); o[1] = __builtin_amdgcn_mfma_f32_32x32x16_bf16(pa, PK(l, h), o[1], 0, 0, 0); }
    { const s16x4 l = tr_read<v_rd_off(2, KS, 0)>(vb), h = tr_read<v_rd_off(2, KS, 1)>(vb); o[2] = __builtin_amdgcn_mfma_f32_32x32x16_bf16(pa, PK(l, h), o[2], 0, 0, 0); }
    { const s16x4 l = tr_read<v_rd_off(3, KS, 0)>(vb), h = tr_read<v_rd_off(3, KS, 1)>(vb); o[3] = __builtin_amdgcn_mfma_f32_32x32x16_bf16(pa, PK(l, h), o[3], 0, 0, 0); }
#undef PK
}
__device__ __forceinline__ void pv_d0(f32x16* o, const LAS char* vb, bf16x8 pa0, bf16x8 pa1, bf16x8 pa2, bf16x8 pa3) {
    pv_step<0>(o, vb, pa0); pv_step<1>(o, vb, pa1); pv_step<2>(o, vb, pa2); pv_step<3>(o, vb, pa3);
}
__device__ __forceinline__ void bias_tile(f32x16& p0, f32x16& p1, int hi, const LAS float* bt, int relbase) {
#pragma unroll
    for (int r = 0; r < 16; ++r) { const int kc = (r & 3) + 8 * (r >> 2); int i0 = relbase + kc + 4 * hi; i0 = i0 < 0 ? 0 : i0; int i1 = relbase + 32 + kc + 4 * hi; i1 = i1 < 0 ? 0 : i1;
        p0[r] += bt[i0]; p1[r] += bt[i1]; }
}
__device__ __forceinline__ void mask_tile(f32x16& p0, f32x16& p1, unsigned long long mw, int hi) {
    const float ninf = -__builtin_inff();
    const unsigned lo = (unsigned)mw >> (4 * hi), hw = (unsigned)(mw >> 32) >> (4 * hi);
#pragma unroll
    for (int r = 0; r < 16; ++r) { const unsigned bit = 1u << ((r & 3) + 8 * (r >> 2)); p0[r] = (lo & bit) ? p0[r] : ninf; p1[r] = (hw & bit) ? p1[r] : ninf; }
}
__device__ __forceinline__ void qkt_m(f32x16& p0, f32x16& p1, const LAS char* Ks, const bf16x8* qr, int r32, int hi, unsigned long long mw) {
    const int nlo = (int)~((unsigned)mw >> (4 * hi)), nhw = (int)~((unsigned)(mw >> 32) >> (4 * hi));
#pragma unroll
    for (int r = 0; r < 16; ++r) { const unsigned pos = (r & 3) + 8 * (r >> 2);
        p0[r] = __uint_as_float((unsigned)__builtin_amdgcn_sbfe(nlo, pos, 1u) & 0xff800000u); p1[r] = __uint_as_float((unsigned)__builtin_amdgcn_sbfe(nhw, pos, 1u) & 0xff800000u); }
#pragma unroll
    for (int d0 = 0; d0 < 8; ++d0) { const int cb = (d0 * 16 + hi * 8) * 2;
        const bf16x8 b0 = *(const LAS bf16x8*)(Ks + KSWZ(r32, cb));
        const bf16x8 b1 = *(const LAS bf16x8*)(Ks + KSWZ(32 + r32, cb));
        p0 = __builtin_amdgcn_mfma_f32_32x32x16_bf16(b0, qr[d0], p0, 0, 0, 0);
        p1 = __builtin_amdgcn_mfma_f32_32x32x16_bf16(b1, qr[d0], p1, 0, 0, 0); }
}
__device__ __forceinline__ int t5_bucket(int rel) {
    const int n = rel < 0 ? -rel : rel; int bk;
    if (n < 8) bk = n; else if (n < 12) bk = 8; else if (n < 16) bk = 9; else if (n < 23) bk = 10; else if (n < 32) bk = 11; else if (n < 46) bk = 12; else if (n < 64) bk = 13; else if (n < 91) bk = 14; else bk = 15;
    return bk + (rel > 0 ? 16 : 0);
}

template <int PVAR> __device__ __forceinline__ void attn_unit(const bf16_t* __restrict__ Q, const bf16_t* __restrict__ K, const bf16_t* __restrict__ V, const unsigned long long* __restrict__ mask,
                                          const float* __restrict__ rel_bias, unsigned char* __restrict__ mix, int b, int kvh, int n, LAS char* lds) {
#define PV_ON(bit) (!(PVAR & (bit)))
    const int tid = tid_l(), wid = tid >> 6, lane = tid & 63, r32 = lane & 31, hi = lane >> 5;
    const int hl = wid >> 1, qsub = wid & 1, hq = kvh * 4 + hl, tq = 64 * n + 32 * qsub + r32;
    LAS char* V_lds = lds; LAS char* K_lds = lds + NBUF * SHM_V;
    LAS float* wsw = (LAS float*)(lds + OFF_WS) + wid * 64; LAS float* li_l = wsw; LAS float* al_l = wsw + 32;
    LAS float* btab = (LAS float*)(lds + OFF_BIAS);
    for (int i = tid; i < 4 * 160; i += 512) { const int h4 = i / 160, idx = i % 160; const int rel = idx - 91; float v = 0.f;
        if (idx < 155) v = (rel_bias[t5_bucket(rel) * AH + kvh * 4 + h4] - rel_bias[15 * AH + kvh * 4 + h4]) * LOG2E;
        btab[i] = v; }
    float m_reg = -1e30f, l_reg = 0; f32x16 o[4] = {}; bf16x8 qr[8];
    const bf16_t* Qw = Q + (size_t)(b * SEQ + tq) * 1024 + hq * 128 + hi * 8;
#pragma unroll
    for (int d0 = 0; d0 < 8; ++d0) qr[d0] = *(const bf16x8*)(Qw + d0 * 16);
    const bf16_t* Kh = K + (size_t)b * SEQ * 256 + kvh * 128; const bf16_t* Vh = V + (size_t)b * SEQ * 256 + kvh * 128;
    const unsigned long long* mrow = mask + (size_t)(b * SEQ + tq) * 64;
    const LAS float* bt = btab + hl * 160;
    const int sr = tid >> 4, sc = (tid & 15) * 8, vst0 = v_st(sr, sc), vst1 = v_st(32 + sr, sc);
    const LAS char* vb0 = V_lds + v_rd_base(lane);
    bf16x8 sv0, sv1, sk0, sk1;
#define SLOAD(k0) do { sv0 = *(const bf16x8*)(&Vh[(size_t)((k0) + sr) * 256 + sc]); sv1 = *(const bf16x8*)(&Vh[(size_t)((k0) + 32 + sr) * 256 + sc]); \
    sk0 = *(const bf16x8*)(&Kh[(size_t)((k0) + sr) * 256 + sc]); sk1 = *(const bf16x8*)(&Kh[(size_t)((k0) + 32 + sr) * 256 + sc]); } while (0)
#define SWRITE(bb) do { *(LAS bf16x8*)(V_lds + (bb) * SHM_V + vst0) = sv0; *(LAS bf16x8*)(V_lds + (bb) * SHM_V + vst1) = sv1; const int kc = sc * 2; \
    *(LAS bf16x8*)(K_lds + (bb) * SHM_K + KSWZ(sr, kc)) = sk0; *(LAS bf16x8*)(K_lds + (bb) * SHM_K + KSWZ(32 + sr, kc)) = sk1; } while (0)
#define RESC(a) do { if (__any((a) < 1.f)) { if (hi == 0) al_l[r32] = (a); asm volatile("s_waitcnt lgkmcnt(0)" ::: "memory"); \
    _Pragma("unroll") for (int d = 0; d < 4; ++d) _Pragma("unroll") for (int r = 0; r < 16; ++r) o[d][r] *= al_l[crow(r, hi)]; } } while (0)
    f32x16 pA0, pA1, pB0, pB1; float mnA, mnB, alA, alB; bf16x8 pa0, pa1, pa2, pa3;
    const int NT = (n + 2) & ~1;
#define BIAST(P0, P1, kt) do { if ((kt) + 2 >= n && (kt) <= n) bias_tile(P0, P1, hi, bt, 64 * ((kt) - n) - 32 * qsub - r32 + 91); } while (0)
#define SG_R1() do { _Pragma("unroll") for (int g_ = 0; g_ < 16; ++g_) { __builtin_amdgcn_sched_group_barrier(0x008, 1, 0); __builtin_amdgcn_sched_group_barrier(0x100, 1, 0); __builtin_amdgcn_sched_group_barrier(0x002, 5, 0); } } while (0)
#define SG_R2() do { _Pragma("unroll") for (int g_ = 0; g_ < 16; ++g_) { __builtin_amdgcn_sched_group_barrier(0x008, 1, 0); __builtin_amdgcn_sched_group_barrier(0x100, 2, 0); __builtin_amdgcn_sched_group_barrier(0x002, 12, 0); } } while (0)
    unsigned long long mwA = mrow[0], mwB = mrow[1];
    SLOAD(0); asm volatile("s_waitcnt vmcnt(0)" ::: "memory"); SWRITE(0); SLOAD(KVBLK); __syncthreads();
    qkt(pA0, pA1, K_lds, qr, r32, hi); BIAST(pA0, pA1, 0); mask_tile(pA0, pA1, mwA, hi); partialSM(pA0, pA1, m_reg, mnA, alA);
    SWRITE(1); if (2 < NT) SLOAD(2 * KVBLK); __syncthreads();
    int b0 = 0, b1 = 1, b2 = 2;
    for (int j = 1; j + 1 < NT; j += 2) {
        if constexpr ((PVAR & 7) == 0) {
        SBAR(); qkt_m(pB0, pB1, K_lds + b1 * SHM_K, qr, r32, hi, mwB);
        finishSM(pA0, pA1, alA, l_reg, pa0, pa1, pa2, pa3); SG_R1(); SBAR();
        BIAST(pB0, pB1, j);
        SBAR(); pv_d0(o, vb0 + b0 * SHM_V, pa0, pa1, pa2, pa3); partialSM(pB0, pB1, m_reg, mnB, alB); SG_R2(); SBAR();
        RESC(alB);
        SWRITE(b2); mwA = mrow[j + 1]; SLOAD((j + 2) * KVBLK);
        __syncthreads();
        SBAR(); qkt_m(pA0, pA1, K_lds + b2 * SHM_K, qr, r32, hi, mwA);
        finishSM(pB0, pB1, alB, l_reg, pa0, pa1, pa2, pa3); SG_R1(); SBAR();
        BIAST(pA0, pA1, j + 1);
        SBAR(); pv_d0(o, vb0 + b1 * SHM_V, pa0, pa1, pa2, pa3); partialSM(pA0, pA1, m_reg, mnA, alA); SG_R2(); SBAR();
        RESC(alA);
        SWRITE(b0); mwB = mrow[j + 2]; if (j + 3 < NT) SLOAD((j + 3) * KVBLK);
        __syncthreads();
        { const int t0_ = b0; b0 = b2; b2 = b1; b1 = t0_; }
        } else {
        if constexpr (PV_ON(2)) qkt(pB0, pB1, K_lds + b1 * SHM_K, qr, r32, hi);
        if constexpr (PV_ON(1)) { finishSM(pA0, pA1, alA, l_reg, pa0, pa1, pa2, pa3); BIAST(pB0, pB1, j); }
        if constexpr (PV_ON(2)) pv_d0(o, vb0 + b0 * SHM_V, pa0, pa1, pa2, pa3);
        if constexpr (PV_ON(1)) { mask_tile(pB0, pB1, mwB, hi); partialSM(pB0, pB1, m_reg, mnB, alB); RESC(alB); }
        if constexpr (PV_ON(4)) { SWRITE(b2); mwA = mrow[j + 1]; SLOAD((j + 2) * KVBLK); }
        __syncthreads();
        if constexpr (PV_ON(2)) qkt(pA0, pA1, K_lds + b2 * SHM_K, qr, r32, hi);
        if constexpr (PV_ON(1)) { finishSM(pB0, pB1, alB, l_reg, pa0, pa1, pa2, pa3); BIAST(pA0, pA1, j + 1); }
        if constexpr (PV_ON(2)) pv_d0(o, vb0 + b1 * SHM_V, pa0, pa1, pa2, pa3);
        if constexpr (PV_ON(1)) { mask_tile(pA0, pA1, mwA, hi); partialSM(pA0, pA1, m_reg, mnA, alA); RESC(alA); }
        if constexpr (PV_ON(4)) { SWRITE(b0); mwB = mrow[j + 2]; if (j + 3 < NT) SLOAD((j + 3) * KVBLK); }
        __syncthreads();
        { const int t0_ = b0; b0 = b2; b2 = b1; b1 = t0_; }
        }
    }
    SBAR(); qkt_m(pB0, pB1, K_lds + b1 * SHM_K, qr, r32, hi, mwB);
    finishSM(pA0, pA1, alA, l_reg, pa0, pa1, pa2, pa3); SG_R1(); SBAR();
    BIAST(pB0, pB1, NT - 1);
    SBAR(); pv_d0(o, vb0 + b0 * SHM_V, pa0, pa1, pa2, pa3); partialSM(pB0, pB1, m_reg, mnB, alB); SG_R2(); SBAR();
    RESC(alB);
    finishSM(pB0, pB1, alB, l_reg, pa0, pa1, pa2, pa3); SBAR();
    pv_d0(o, vb0 + b1 * SHM_V, pa0, pa1, pa2, pa3);
#undef BIAST
#undef SG_R1
#undef SG_R2
    if (hi == 0) li_l[r32] = l_reg; asm volatile("s_waitcnt lgkmcnt(0)" ::: "memory");
    float rli[16];
#pragma unroll
    for (int r = 0; r < 16; ++r) rli[r] = __builtin_amdgcn_rcpf(li_l[crow(r, hi)]);
    unsigned char* Ow = mix + (size_t)(b * SEQ + 64 * n + 32 * qsub) * DM + hq * 128;
#pragma unroll
    for (int r = 0; r < 16; ++r) { const int orow = crow(r, hi);
#pragma unroll
        for (int d0 = 0; d0 < 4; ++d0) Ow[(size_t)orow * DM + d0 * 32 + r32] = (unsigned char)(cvt_pk4_fp8(o[d0][r] * (rli[r] * S_MIX8), 0.f, 0.f, 0.f) & 0xffu); }
    __syncthreads();
#undef SLOAD
#undef SWRITE
#undef RESC
}
}

template <int PVAR> __device__ __forceinline__ void phase_attn(Ctx& C) {
    const int tidl = tid_l(), lane = tidl & 63; (void)lane;
    unsigned char* const wsl = launder(C.ws); unsigned* const ctll = (unsigned*)(wsl + WS_CTL); (void)ctll;
    const bf16_t* Q = (const bf16_t*)(wsl + WS_PROJ + PJ_Q); const bf16_t* K = (const bf16_t*)(wsl + WS_PROJ + PJ_K); const bf16_t* V = (const bf16_t*)(wsl + WS_PROJ + PJ_V);
    const unsigned long long* mask = (const unsigned long long*)(wsl + WS_MASK); unsigned char* mix = (unsigned char*)(wsl + WS_MIX);
    for (int p = C.bx; p < 256; p += C.G) { const int j = p >> 3, bk = p & 7;
        at::attn_unit<PVAR>(Q, K, V, mask, KIN(1), mix, bk >> 1, bk & 1, 63 - j, (LAS char*)C.lds);
        at::attn_unit<PVAR>(Q, K, V, mask, KIN(1), mix, bk >> 1, bk & 1, j, (LAS char*)C.lds); }
}

constexpr int NWAVES = 8;
constexpr int RING_BYTES = 131072, MISC_OFF = 143360, LDS_BYTES = 147456;
constexpr int PH_PER_LAYER = 10, NPH = 1 + NLAYER * PH_PER_LAYER;
#ifndef STG_INPROJ
#define STG_INPROJ 250u
#endif
#ifndef MK_PER_PHASE
#define MK_PER_PHASE 0
#endif


__device__ __forceinline__ Ctx make_ctx() {
    extern __shared__ __attribute__((aligned(16))) unsigned char lds_raw[];
    Ctx C; C.lds = (LAS unsigned char*)lds_raw; KArgs ka = kargs(); C.ws = as_global((unsigned char*)ka->ws); C.ctl = (unsigned*)(C.ws + WS_CTL);
    C.wave = __builtin_amdgcn_readfirstlane(tid_l() >> 6); int bx = (int)blockIdx.x; asm volatile("" : "+s"(bx)); C.bx = bx; C.G = gridDim.x; C.gw = bx * NWAVES + C.wave; C.NGW = C.G * NWAVES; return C;
}
__device__ __forceinline__ void seam() {
    extern __shared__ __attribute__((aligned(16))) unsigned char lds_raw[];
    XcdBarrier b; b.bar = as_global((unsigned*)((unsigned char*)kargs()->ws + WS_CTL) + CW_BAR); b.x = xb_xcc_id(); b.st = (volatile LAS unsigned*)((LAS unsigned char*)lds_raw + MISC_OFF) + 8;
    xcd_barrier(b);
}
#ifndef ONLY
#define ONLY -1
#endif
#define SITE(s) (ONLY < 0 || ONLY == (s))
#define IN(k) (kargs()->ph_lo <= (k) && (k) < kargs()->ph_hi)
#define SEAM(k) do { if (IN((k) + 1)) seam(); } while (0)
#ifndef PROBE_DUP
#define PROBE_DUP -1
#endif
#ifndef PROBE_DUP2
#define PROBE_DUP2 -1
#endif
#ifndef PROBE_DUP3
#define PROBE_DUP3 -1
#endif
#ifndef PROBE_DUP4
#define PROBE_DUP4 -1
#endif
#define DUPX(s)
#define DUP_UNUSED(s) for (int rep_ = 0; rep_ < ((PROBE_DUP == (s) || PROBE_DUP2 == (s) || PROBE_DUP3 == (s) || PROBE_DUP4 == (s)) ? 2 : 1); ++rep_)
#define CTX() Ctx C = make_ctx(); LAS unsigned char* const ring = C.lds; (void)ring
#define LSITE 0
template <int l, int PVAR> __device__ __forceinline__ void layer_program() {
    constexpr int pb = 1 + l * PH_PER_LAYER;
#define SUB_BEGIN { CTX(); unsigned char* const wsl = launder(C.ws); unsigned char* const pj = wsl + WS_PROJ; const float* const rstd = (const float*)(wsl + WS_SMALL + SM_RSTD); (void)pj; (void)rstd; (void)ring;
#define SUB_END }
#define SITE_BEGIN(sid, k) if (SITE(sid) && IN(pb + (k))) { SUB_BEGIN
#define SITE_END(k) SUB_END SEAM(pb + (k)); }
    if constexpr (l != 0) { SITE_BEGIN(0, 0) phase_rstd(C); SITE_END(0) }
    SITE_BEGIN(1, 1)
        SchedDense S{(const char*)(wsl + WS_HB8), (const char*)(wsl + WS_W_IN) + (size_t)l * INP * DM, DM, DM, NTOK / 256, INP / 256, DM / 128, C.G, C.bx};
        EpiInProj<true> E{pj, rstd, (const float*)(wsl + WS_ROPE), (const float*)(wsl + WS_ROPE) + SEQ * 128, (const float*)(wsl + WS_SMALL + SM_SA), (const float*)(wsl + WS_SMALL + SM_SBIN) + l * (INP / 256)};
        gm::gemm_phase<EpiInProj<true>, SchedDense, false, 2, (PVAR >> 8) & 15>(ring, S, E, DM, DM);
    SITE_END(1)
    SITE_BEGIN(2, 2)
          SchedRetTile S{(const char*)(pj + PJ_QP), (const char*)(pj + PJ_RK), 256 * 512 * 2, 0, 4, C.G, C.bx, 256 * 1024 * 2};
          EpiRetP E{(bf16_t*)(pj + PJ_QP)};
          if constexpr (!(PVAR & 0x4000)) gm::gemm_phase<EpiRetP, SchedRetTile, false>(ring, S, E, 512 * 2, 1024 * 2); SUB_END
        SUB_BEGIN SchedRetTile S{(const char*)(pj + PJ_SV) + 512, (const char*)(pj + PJ_KT), 256 * 512 * 2, 256 * 256 * 2, 4, C.G, C.bx, 0};
          EpiRetKV E{(float*)(pj + PJ_KVT)};
          if constexpr (!(PVAR & 0x4000)) gm::gemm_phase<EpiRetKV, SchedRetTile, false>(ring, S, E, 512 * 2, 256 * 2); SUB_END
        SUB_BEGIN if constexpr (!(PVAR & 0x2000)) phase_post(C, l); SUB_END
        SUB_BEGIN if constexpr (!(PVAR & 0x1000)) phase_scores(C);
    SITE_END(2)
    SITE_BEGIN(3, 3) if constexpr (!(PVAR & 0x8000)) phase_select(C); SUB_END SUB_BEGIN if constexpr (!(PVAR & 0x10000)) phase_retscan(C); SITE_END(3)
    SITE_BEGIN(4, 4) phase_attn<PVAR>(C); SUB_END
        SUB_BEGIN SchedRetTile S{(const char*)(pj + PJ_QP), (const char*)(pj + PJ_SV), 256 * 512 * 2, 256 * 512 * 2, 8, C.G, C.bx, 0};
          EpiRetOut E{(unsigned char*)(wsl + WS_MIX), (const bf16_t*)(pj + PJ_RG), KIN(6) + l * 1024, C.lds + RING_BYTES};
          if constexpr (!(PVAR & 8)) gm::gemm_phase<EpiRetOut, SchedRetTile, false>(ring, S, E, 512 * 2, 512 * 2);
    SITE_END(4)
    SITE_BEGIN(5, 5)
        SchedDense S{(const char*)(wsl + WS_MIX), (const char*)(wsl + WS_W_OUT) + (size_t)l * DM * DM, DM, DM, NTOK / 256, DM / 256, DM / 128, C.G, C.bx};
        EpiResid<l == 0> E{KIN(0), (bf16_t*)(wsl + WS_HB), 1.0f / (S_MIX8 * S_WOUT8)};
        gm::gemm_phase<EpiResid<l == 0>, SchedDense, false, 1>(ring, S, E, DM, DM);
    SITE_END(5)
    if constexpr (l == 0) {
        SITE_BEGIN(6, 6) phase_rstd(C); SITE_END(6)
        SITE_BEGIN(7, 7)
            SchedDense S{(const char*)(wsl + WS_HB8), (const char*)(wsl + WS_W_FUP), DM, DM, NTOK / 256, 2 * DFF / 256, DM / 128, C.G, C.bx};
            EpiFfnUp<true> E{(unsigned char*)(wsl + WS_BIG), rstd, (const float*)(wsl + WS_SMALL + SM_SA), (const float*)(wsl + WS_SMALL + SM_SBF)};
            gm::gemm_phase<EpiFfnUp<true>, SchedDense, false, 2>(ring, S, E, DM, DM);
        SITE_END(7)
        SITE_BEGIN(8, 8)
            SchedDense S{(const char*)(wsl + WS_BIG), (const char*)(wsl + WS_W_FDN), DFF, DFF, NTOK / 256, DM / 256, DFF / 128, C.G, C.bx};
            EpiResid<false> E{nullptr, (bf16_t*)(wsl + WS_HB), 1.0f / (S_H8 * S_WDN8)};
            gm::gemm_phase<EpiResid<false>, SchedDense, false, 1>(ring, S, E, DFF, DFF);
        SITE_END(8)
    } else {
        SITE_BEGIN(26, 6) phase_stats<true>(C, nullptr, l); SITE_END(6)
        SITE_BEGIN(27, 7)
            SchedMoeUp S{moe_info((unsigned*)(wsl + WS_CTL)), (const char*)(wsl + WS_HB8), (const char*)(wsl + WS_W_MUP), (const int*)(wsl + WS_SMALL + SM_LIST), C.G, C.bx};
            EpiMoeUp E{(unsigned char*)(wsl + WS_BIG), (const float*)(wsl + WS_SMALL + SM_RFAC), (const int*)(wsl + WS_SMALL + SM_LIST)};
            gm::gemm_phase<EpiMoeUp, SchedMoeUp, true, 1, (PVAR >> 4) & 7>(ring, S, E, DM, DM);
        SITE_END(7)
        SITE_BEGIN(28, 8)
            SchedMoeDown S{moe_info((unsigned*)(wsl + WS_CTL)), (const char*)(wsl + WS_BIG), (const char*)(wsl + WS_W_MDN), C.G, C.bx};
            EpiMoeDown E{(bf16_t*)(pj + PJ_Y)};
            gm::gemm_phase<EpiMoeDown, SchedMoeDown, false, 1>(ring, S, E, DFE, DFE);
        SITE_END(8)
        SITE_BEGIN(29, 9) phase_combine(C); SITE_END(9)
    }
#undef SITE_BEGIN
#undef SITE_END
#undef SUB_BEGIN
#undef SUB_END
}
template <int PVAR> __global__ void __launch_bounds__(NWAVES * 64, 2) mk_fwd_t(Args args) {
    extern __shared__ __attribute__((aligned(16))) unsigned char lds_raw[];
    {
        volatile LAS unsigned* MISC = (volatile LAS unsigned*)((LAS unsigned char*)lds_raw + MISC_OFF);
        if ((int)threadIdx.x < 32) MISC[(int)threadIdx.x] = 0u;
        __syncthreads();
        if (args.use_bar) (void)xcd_barrier_post((unsigned*)(args.ws + WS_CTL) + CW_BAR, MISC + 8);
    }

    if (SITE(100) && IN(0)) { { CTX(); phase_prepA(C); } { CTX(); phase_stats<false>(C, KIN(0), 0); } SEAM(0); }

    layer_program<0, PVAR>();
    layer_program<1, PVAR>();
#undef IN
#undef SEAM
}

extern "C" void kernel_launch(void* const* d_in, const int* in_sizes, int n_in, void* d_out, int out_size, void* d_ws, size_t ws_size, hipStream_t stream) {
    static int grid = 0;
    if (grid == 0) {
        if (n_in != 16 || out_size != NTOK * DM || ws_size < WS_END) { fprintf(stderr, "kernel_launch: unexpected shapes (n_in %d out %d ws %zu, need %zu)\n", n_in, out_size, ws_size, (size_t)WS_END); grid = -1; return; }
        int dev = 0, cus = 0, per_cu = 0;
        if (hipGetDevice(&dev) != hipSuccess || hipDeviceGetAttribute(&cus, hipDeviceAttributeMultiprocessorCount, dev) != hipSuccess) { grid = -1; return; }
        if (hipFuncSetAttribute((const void*)mk_fwd_t<0>, hipFuncAttributeMaxDynamicSharedMemorySize, LDS_BYTES) != hipSuccess) { fprintf(stderr, "kernel_launch: hipFuncSetAttribute failed\n"); grid = -1; return; }
        if (hipOccupancyMaxActiveBlocksPerMultiprocessor(&per_cu, (const void*)mk_fwd_t<0>, NWAVES * 64, LDS_BYTES) != hipSuccess || per_cu < 1) { fprintf(stderr, "kernel_launch: occupancy query says %d\n", per_cu); }
        (void)hipGetLastError();
        grid = cus;
    }
    if (grid < 0) return;
    if (hipMemsetAsync((char*)d_ws + WS_CTL, 0, CTL_ZERO_BYTES, stream) != hipSuccess) return;
    Args a{};
    for (int i = 0; i < 16; ++i) a.in[i] = (const float*)d_in[i];
    a.out = (float*)d_out; a.ws = (unsigned char*)d_ws; a.pad = 0;
#if MK_PER_PHASE
    for (int ph = 0; ph < NPH; ++ph) {
        if (ph == 1 + 9 || ph == 1) continue;
        a.ph_lo = ph; a.ph_hi = ph + 1; a.use_bar = 0;
#ifdef PROBE_PH
#ifndef PROBE_VAR
#define PROBE_VAR 0
#endif
        { const int pr[] = {PROBE_PH}; for (int q = 0; q < (int)(sizeof(pr) / sizeof(int)); ++q) if (pr[q] == ph) { hipFuncSetAttribute((const void*)mk_fwd_t<PROBE_VAR>, hipFuncAttributeMaxDynamicSharedMemorySize, LDS_BYTES); hipLaunchKernelGGL(mk_fwd_t<PROBE_VAR>, dim3(grid), dim3(NWAVES * 64), LDS_BYTES, stream, a); } }
#endif
        hipLaunchKernelGGL(mk_fwd_t<0>, dim3(grid), dim3(NWAVES * 64), LDS_BYTES, stream, a);

    }
#else
    a.ph_lo = 0; a.ph_hi = NPH; a.use_bar = 1;
    hipLaunchKernelGGL(mk_fwd_t<0>, dim3(grid), dim3(NWAVES * 64), LDS_BYTES, stream, a);
#endif
    const hipError_t le = hipPeekAtLastError();
    if (le != hipSuccess) fprintf(stderr, "kernel_launch: launch failed: %s\n", hipGetErrorName(le));
}
```

```cpp
#include <hip/hip_runtime.h>
#include <cstdio>
#include <cstdint>

#define LAS __attribute__((address_space(3)))
#define GAS __attribute__((address_space(1)))
typedef unsigned short bf16_t;
typedef short bf16x8 __attribute__((ext_vector_type(8)));
typedef short s16x4 __attribute__((ext_vector_type(4)));
typedef float f32x2 __attribute__((ext_vector_type(2)));
typedef float f32x4 __attribute__((ext_vector_type(4)));
typedef float f32x16 __attribute__((ext_vector_type(16)));
typedef unsigned u32x2 __attribute__((ext_vector_type(2)));
typedef unsigned u32x4 __attribute__((ext_vector_type(4)));
typedef int i32x8 __attribute__((ext_vector_type(8)));
typedef int i32x4 __attribute__((ext_vector_type(4)));

constexpr int DM = 2048, NBATCH = 4, SEQ = 4096, NTOK = NBATCH * SEQ;
constexpr int AH = 8, AKV = 2, AD = 128, IH = 16, IDIM = 64, RH = 4, RD = 256;
constexpr int INW = 6736, INP = 6912;
constexpr int DFF = 5632, NE = 8, DFE = 7168;
constexpr int NLAYER = 2;
constexpr float EPS = 1e-6f, GN_EPS = 1e-5f;
constexpr float LOG2E = 1.4426950408889634f;

constexpr size_t MiB = 1u << 20;
constexpr size_t WS_CTL = 0, CTL_ZERO_BYTES = 1 * MiB;
constexpr size_t WS_SMALL = 1 * MiB;
constexpr size_t WS_ROPE = 9 * MiB;
constexpr size_t WS_W_IN = 13 * MiB, WS_W_FUP = 83 * MiB, WS_W_OUT = 67 * MiB, WS_W_FDN = 127 * MiB, WS_W_MUP = 149 * MiB, WS_W_MDN = 373 * MiB;
constexpr size_t WS_HB = 485 * MiB, WS_HB8 = 549 * MiB, WS_MASK = 581 * MiB, WS_MIX = 589 * MiB, WS_PROJ = 653 * MiB, WS_BIG = 1024 * MiB, WS_END = 1280 * MiB;
constexpr float S_HB8 = 8.f, S_WUP8 = 64.f, S_H8 = 4.f, S_WDN8 = 128.f, S_MIX8 = 4.f, S_WOUT8 = 64.f;
constexpr size_t PJ_Q = 0, PJ_K = 32 * MiB, PJ_V = 40 * MiB, PJ_IQ = 48 * MiB, PJ_IK = 80 * MiB, PJ_IW = 82 * MiB, PJ_RG = 83 * MiB, PJ_QP = 115 * MiB,
                 PJ_SV = 179 * MiB, PJ_KT = 243 * MiB, PJ_RK = 275 * MiB, PJ_KVT = 307 * MiB;
constexpr size_t PJ_Y = 0;
constexpr size_t SM_RFAC = 2 * 1024 * 1024;
constexpr size_t SM_SA = 1024 * 1024, SM_SBIN = SM_SA + 64 * 1024, SM_SBF = SM_SBIN + 64 * 1024;
constexpr size_t SM_RSTD = 0, SM_TOKE = 64 * 1024, SM_TOKS = SM_TOKE + 128 * 1024, SM_TOKG = SM_TOKS + 128 * 1024, SM_LIST = SM_TOKG + 128 * 1024;
constexpr int CW_CNT = 64;
constexpr int CW_BAR = 4096;
constexpr int CW_QUEUE = 3072;
constexpr int CW_CMAX_IN = 16384, CW_CMAX_F = CW_CMAX_IN + 64;

typedef __bf16 bf16v2 __attribute__((ext_vector_type(2)));
__device__ __forceinline__ unsigned cvt_pk_bf16(float lo, float hi) { const f32x2 x = {lo, hi}; return __builtin_bit_cast(unsigned, __builtin_convertvector(x, bf16v2)); }
__device__ __forceinline__ unsigned cvt_pk4_fp8(float a, float b, float c, float d) { int w = __builtin_amdgcn_cvt_pk_fp8_f32(a, b, 0, false); w = __builtin_amdgcn_cvt_pk_fp8_f32(c, d, w, true); return (unsigned)w; }
__device__ __forceinline__ unsigned cvt_pk4_fp8c(float a, float b, float c, float d) { return cvt_pk4_fp8(__builtin_amdgcn_fmed3f(a, -448.f, 448.f), __builtin_amdgcn_fmed3f(b, -448.f, 448.f), __builtin_amdgcn_fmed3f(c, -448.f, 448.f), __builtin_amdgcn_fmed3f(d, -448.f, 448.f)); }
__device__ __forceinline__ unsigned pk4_i8(float a, float b, float c, float d) { return ((unsigned)__float2int_rn(a) & 255u) | (((unsigned)__float2int_rn(b) & 255u) << 8) | (((unsigned)__float2int_rn(c) & 255u) << 16) | ((unsigned)__float2int_rn(d) << 24); }
__device__ __forceinline__ float bf_lo(unsigned w) { return __uint_as_float(w << 16); }
__device__ __forceinline__ float bf_hi(unsigned w) { return __uint_as_float(w & 0xffff0000u); }
__device__ __forceinline__ float wave_sum(float v) {
#pragma unroll
    for (int o = 1; o < 64; o <<= 1) v += __shfl_xor(v, o);
    return v;
}
template <class T> __device__ __forceinline__ T* as_global(T* p) { return p; }
template <class T> __device__ __forceinline__ T* launder(T* p) { __attribute__((address_space(1))) T* g = (__attribute__((address_space(1))) T*)p; asm volatile("" : "+s"(g)); return (T*)g; }
__device__ __forceinline__ int tid_l() { int t = (int)threadIdx.x; asm volatile("" : "+v"(t)); return t; }
__device__ __forceinline__ void stagger(int bx, unsigned ticks) { const unsigned long long t0 = __builtin_amdgcn_s_memrealtime(); const unsigned long long d = (unsigned long long)(bx & 7) * ticks;
    while (__builtin_amdgcn_s_memrealtime() - t0 < d) __builtin_amdgcn_s_sleep(8); }
#define LDS_WAIT() asm volatile("s_waitcnt lgkmcnt(0)" ::: "memory")
#define VM_WAIT() asm volatile("s_waitcnt vmcnt(0)" ::: "memory")

#define XB_TMO      128
#define XB_XCNT(j)  (256  + 64 * (j))
#define XB_XSUB(j)  (1280 + 64 * (j))
#define XB_XGEN(j)  (2304 + 64 * (j))
#define XB_TOP      3328
#define XB_TOPGEN   3392
#define XCD_BAR_WORDS 3456
#define XB_SPIN_CAP (1u << 22)
__device__ __forceinline__ unsigned xb_ld(unsigned* p)              { return __hip_atomic_load(p, __ATOMIC_RELAXED, __HIP_MEMORY_SCOPE_AGENT); }
__device__ __forceinline__ unsigned xb_add(unsigned* p, unsigned v) { return __hip_atomic_fetch_add(p, v, __ATOMIC_RELAXED, __HIP_MEMORY_SCOPE_AGENT); }
__device__ __forceinline__ unsigned xb_xcc_id() { return (unsigned)__builtin_amdgcn_s_getreg((3 << 11) | 20) & 0xFu; }
#define XB_SPIN(cond, bar) do { unsigned _sp = 0; while (cond) { __builtin_amdgcn_s_sleep(1); \
    if ((++_sp & 255u) == 0u) { if (xb_ld(&(bar)[XB_TMO])) break; if (_sp > XB_SPIN_CAP) { atomicAdd(&(bar)[XB_TMO], 1u); break; } } } } while (0)
struct XcdBarrier { unsigned* bar; unsigned x; volatile LAS unsigned* st; };
__device__ __forceinline__ XcdBarrier xcd_barrier_post(unsigned* bar, volatile LAS unsigned* st) {
    XcdBarrier b; b.bar = bar; b.x = xb_xcc_id(); b.st = st;
    if (threadIdx.x == 0) (void)xb_add(&bar[XB_XCNT(b.x)], 1u);
    return b;
}
__device__ __forceinline__ void xcd_barrier_complete(unsigned* bar, unsigned x, unsigned& nloc, unsigned& nx) {
    const unsigned G = gridDim.x * gridDim.y * gridDim.z;
    unsigned sum, cnt, mine, sp = 0u;
    for (;;) {
        sum = 0u; cnt = 0u; mine = 0u;
#pragma unroll
        for (unsigned j = 0; j < 16; ++j) { const unsigned c = xb_ld(&bar[XB_XCNT(j)]); sum += c; cnt += (c > 0u) ? 1u : 0u; mine = (j == x) ? c : mine; }
        if (sum == G) break;
        __builtin_amdgcn_s_sleep(1);
        if ((++sp & 255u) == 0u) { if (xb_ld(&bar[XB_TMO])) break; if (sp > XB_SPIN_CAP) { atomicAdd(&bar[XB_TMO], 1u); break; } }
    }
    nloc = mine > 0u ? mine : 1u; nx = cnt > 0u ? cnt : 1u;
}
__device__ __forceinline__ void xcd_barrier(const XcdBarrier& b) {
    asm volatile("s_waitcnt vmcnt(0)" ::: "memory");
    __syncthreads();
    if (threadIdx.x == 0) {
        unsigned* bar = launder(b.bar); unsigned bx = b.x; asm volatile("" : "+s"(bx));
        __builtin_amdgcn_s_waitcnt(0);
        unsigned nloc = b.st[0], nx = b.st[1];
        if (nloc == 0u) { xcd_barrier_complete(bar, bx, nloc, nx); b.st[0] = nloc; b.st[1] = nx; }
        const unsigned old = xb_add(&bar[XB_XSUB(bx)], 1u);
        const unsigned gen = old / nloc;
        if (old + 1u == (gen + 1u) * nloc) {
            __builtin_amdgcn_fence(__ATOMIC_RELEASE, "agent");
            asm volatile("s_waitcnt vmcnt(0)" ::: "memory");
            const unsigned og = xb_add(&bar[XB_TOP], 1u);
            const unsigned tg = og / nx;
            if (og + 1u == (tg + 1u) * nx) xb_add(&bar[XB_TOPGEN], 1u);
            else XB_SPIN(xb_ld(&bar[XB_TOPGEN]) == tg, bar);
            __builtin_amdgcn_fence(__ATOMIC_ACQUIRE, "agent");
            xb_add(&bar[XB_XGEN(bx)], 1u);
            asm volatile("s_waitcnt vmcnt(0)" ::: "memory");
        } else {
            XB_SPIN(xb_ld(&bar[XB_XGEN(bx)]) == gen, bar);
            __builtin_amdgcn_fence(__ATOMIC_ACQUIRE, "agent");
            asm volatile("s_waitcnt vmcnt(0)" ::: "memory");
        }
    }
    __syncthreads();
}

namespace gm {
constexpr int BM = 256, BK = 64, HALF = 128, HTB = HALF * BK * 2, STAGE_BYTES = 8 * HTB, NXCD = 8, WGM = 4;
__host__ __device__ __forceinline__ int lds_byte(int r, int c) { const int st = (r >> 4) * 2 + (c >> 5), rr = r & 15, cc = c & 31, ob = rr * 64 + cc * 2; return st * 1024 + (ob ^ (((ob >> 9) & 1) << 5)); }
__host__ __device__ __forceinline__ void stage_rc(int b, int& R, int& C) { const int st = b / 1024, sb = b % 1024, swz = sb ^ (((sb >> 9) & 1) << 5); R = (st >> 1) * 16 + swz / 64; C = (st & 1) * 32 + (swz % 64) / 2; }
__host__ __device__ __forceinline__ int perm32(int rho) { const int n = rho >> 4, i = rho & 15; return 8 * (i >> 2) + 4 * n + (i & 3); }

struct Unit { const char* A; const char* B; const int* rows; int pm, pn, nt, aux; };

__device__ __forceinline__ bool tile_order(long L, int nM, int nN, int& pm, int& pn) {
    const int nwg = nM * nN; if (L >= nwg) return false;
    int wgid = (int)L; { const int q = nwg / NXCD, r = nwg % NXCD, xcd = wgid % NXCD, off = wgid / NXCD; wgid = (xcd < r ? xcd * (q + 1) : r * (q + 1) + (xcd - r) * q) + off; }
    const int nig = WGM * nN, gid = wgid / nig, fm = gid * WGM, gsz = (nM - fm) < WGM ? (nM - fm) : WGM;
    pm = fm + ((wgid % nig) % gsz); pn = (wgid % nig) / gsz; return true;
}

template <class Epi, class Sched, bool GATHER, int MODE = 0, int GPV = 0>
__device__ __forceinline__ void gemm_phase(LAS unsigned char* lds, const Sched& S, const Epi& E, const unsigned lda, const unsigned ldb) {
    const int tid = tid_l(), wid = __builtin_amdgcn_readfirstlane(tid >> 6), lane = tid & 63, wr = wid >> 2, wc = wid & 3, fr = lane & 15, fq = lane >> 4;
    int Rr[2]; unsigned Cc[2], voffB[2];
#pragma unroll
    for (int i = 0; i < 2; ++i) { int R, C; stage_rc(tid * 16 + i * 8192, R, C); const int Rb = Epi::PERM ? ((R & ~31) + perm32(R & 31)) : R;
        Rr[i] = R; Cc[i] = (unsigned)C * 2u; voffB[i] = (unsigned)Rb * ldb + (unsigned)C * 2u; }
    const size_t kstep = (size_t)(BK * 2);
    const size_t hstepB = (size_t)HALF * ldb, hstepA = GATHER ? 0 : (size_t)HALF * lda;
    const unsigned ldsw = (unsigned)wid * 1024u;
    const int aoff = lds_byte(wr * 64 + fr, fq * 8), boff = lds_byte(wc * 32 + fr, fq * 8);
#define GM_SA(b, h) (((b) * 2 + (h)) * HTB)
#define GM_SB(b, h) ((4 + (b) * 2 + (h)) * HTB)
#define GM_STAGE_A(bufoff, gbase, offs) do { if constexpr (GPV & 4) break; _Pragma("unroll") for (int _i = 0; _i < 2; ++_i) \
        __builtin_amdgcn_global_load_lds((const unsigned*)((const char*)(gbase) + (offs)[_i]), (LAS unsigned*)(lds + (bufoff) + ldsw + _i * 8192), 16, 0, 0); } while (0)
#define GM_STAGE_B(bufoff, gbase) do { if constexpr (GPV & 4) break; _Pragma("unroll") for (int _i = 0; _i < 2; ++_i) \
        __builtin_amdgcn_global_load_lds((const unsigned*)((const char*)(gbase) + voffB[_i]), (LAS unsigned*)(lds + (bufoff) + ldsw + _i * 8192), 16, 0, 0); } while (0)
#define GM_LDA(dst, b, h) do { _Pragma("unroll") for (int m = 0; m < 4; ++m) _Pragma("unroll") for (int k = 0; k < 2; ++k) dst[m][k] = *(const LAS bf16x8*)(lds + GM_SA(b, h) + aoff + m * 2048 + k * 1024); } while (0)
#define GM_LDB(dst, b, h) do { _Pragma("unroll") for (int n = 0; n < 2; ++n) _Pragma("unroll") for (int k = 0; k < 2; ++k) dst[n][k] = *(const LAS bf16x8*)(lds + GM_SB(b, h) + boff + n * 2048 + k * 1024); } while (0)
#define GM_MMA(ai, bj, At, Bt) do { if constexpr (GPV & 2) { _Pragma("unroll") for (int m = 0; m < 4; ++m) asm volatile("" :: "v"(At[m][0]), "v"(At[m][1])); _Pragma("unroll") for (int n = 0; n < 2; ++n) asm volatile("" :: "v"(Bt[n][0]), "v"(Bt[n][1])); break; } __builtin_amdgcn_s_setprio(1); _Pragma("unroll") for (int m = 0; m < 4; ++m) _Pragma("unroll") for (int n = 0; n < 2; ++n) { \
        if constexpr (MODE == 1) { const i32x8 b8_ = __builtin_shufflevector(__builtin_bit_cast(i32x4, Bt[n][0]), __builtin_bit_cast(i32x4, Bt[n][1]), 0, 1, 2, 3, 4, 5, 6, 7); \
            const i32x8 a8_ = __builtin_shufflevector(__builtin_bit_cast(i32x4, At[m][0]), __builtin_bit_cast(i32x4, At[m][1]), 0, 1, 2, 3, 4, 5, 6, 7); \
            asm volatile("v_mfma_scale_f32_16x16x128_f8f6f4 %0, %1, %2, %0, %3, %3 op_sel_hi:[0,0,0]" : "+v"(acc[ai][bj][m][n]) : "v"(b8_), "v"(a8_), "v"(sc1_)); } \
        else if constexpr (MODE == 2) { i32x4 ci_ = __builtin_bit_cast(i32x4, acc[ai][bj][m][n]); \
            _Pragma("unroll") for (int k = 0; k < 2; ++k) ci_ = __builtin_amdgcn_mfma_i32_16x16x64_i8(__builtin_bit_cast(i32x4, Bt[n][k]), __builtin_bit_cast(i32x4, At[m][k]), ci_, 0, 0, 0); \
            acc[ai][bj][m][n] = __builtin_bit_cast(f32x4, ci_); } \
        else { _Pragma("unroll") for (int k = 0; k < 2; ++k) acc[ai][bj][m][n] = __builtin_amdgcn_mfma_f32_16x16x32_bf16(Bt[n][k], At[m][k], acc[ai][bj][m][n], 0, 0, 0); } } \
        __builtin_amdgcn_s_setprio(0); } while (0)
#define GM_WAIT_V(n) asm volatile("s_waitcnt vmcnt(" #n ")" ::: "memory")
#define GM_WAIT_L(n) asm volatile("s_waitcnt lgkmcnt(" #n ")" ::: "memory")
#define GM_BAR __builtin_amdgcn_s_barrier()
#define GM_SCHED __builtin_amdgcn_sched_barrier(0)
    Unit cur, nxt; int ui = 0;
    if (!S.next(0, cur)) return;
    f32x4 acc[2][2][4][2];
#pragma unroll
    for (int a = 0; a < 2; ++a)
#pragma unroll
        for (int b = 0; b < 2; ++b)
#pragma unroll
            for (int m = 0; m < 4; ++m)
#pragma unroll
                for (int n = 0; n < 2; ++n) acc[a][b][m][n] = (f32x4){0.f, 0.f, 0.f, 0.f};
    bf16x8 At[4][2], B0[2][2], B1[2][2];
    const int sc1_ = 0x7F7F7F7F; (void)sc1_;
    unsigned aoC[2][2], aoN[2][2]; int rowN[2][2];
#pragma unroll
    for (int h = 0; h < 2; ++h)
#pragma unroll
        for (int i = 0; i < 2; ++i) { const int row = h * HALF + Rr[i]; const int rr = GATHER ? cur.rows[row] : Rr[i]; aoC[h][i] = (unsigned)rr * lda + Cc[i]; aoN[h][i] = aoC[h][i]; rowN[h][i] = 0; }
    const char* cA = cur.A; const char* cB = cur.B;
    GM_STAGE_B(GM_SB(0, 0), cB); GM_STAGE_B(GM_SB(0, 1), cB + hstepB); GM_STAGE_A(GM_SA(0, 0), cA, aoC[0]); GM_STAGE_A(GM_SA(0, 1), cA + hstepA, aoC[1]);
    if (wr == 1) GM_BAR;
    GM_WAIT_V(2); GM_BAR;
    GM_STAGE_B(GM_SB(1, 0), cB + kstep); GM_STAGE_A(GM_SA(1, 0), cA + kstep, aoC[0]); GM_STAGE_B(GM_SB(1, 1), cB + hstepB + kstep);
    GM_WAIT_V(6); GM_BAR;
    for (;;) {
        const bool has_next = S.next(ui + 1, nxt);
        const char* nA = has_next ? nxt.A : cA; const char* nB = has_next ? nxt.B : cB;
        if constexpr (GATHER) { if (has_next) {
#pragma unroll
            for (int h = 0; h < 2; ++h)
#pragma unroll
                for (int i = 0; i < 2; ++i) rowN[h][i] = nxt.rows[h * HALF + Rr[i]]; } }
        const int nt = cur.nt;
        for (int t = 0; t < nt; t += 2) {
            const bool last = (t == nt - 2);
            const char* a1 = cA + (size_t)(t + 1) * kstep;
            const char* a2 = last ? nA : cA + (size_t)(t + 2) * kstep; const char* b2 = last ? nB : cB + (size_t)(t + 2) * kstep;
            const char* a3 = a2 + kstep; const char* b3 = b2 + kstep;
            unsigned o2[2][2];
            if constexpr (GATHER) {
                if (last && has_next) {
#pragma unroll
                    for (int h = 0; h < 2; ++h)
#pragma unroll
                        for (int i = 0; i < 2; ++i) aoN[h][i] = (unsigned)rowN[h][i] * lda + Cc[i];
                }
#pragma unroll
                for (int h = 0; h < 2; ++h)
#pragma unroll
                    for (int i = 0; i < 2; ++i) o2[h][i] = last ? aoN[h][i] : aoC[h][i];
            } else {
#pragma unroll
                for (int h = 0; h < 2; ++h)
#pragma unroll
                    for (int i = 0; i < 2; ++i) o2[h][i] = aoC[0][i];
            }
            GM_LDB(B0, 0, 0); GM_LDB(B1, 0, 1); GM_SCHED; GM_LDA(At, 0, 0); GM_STAGE_A(GM_SA(1, 1), a1 + hstepA, aoC[1]);
            GM_WAIT_V(8); GM_WAIT_L(0); GM_BAR; GM_MMA(0, 0, At, B0); GM_MMA(0, 1, At, B1); GM_BAR; GM_SCHED;
            GM_LDA(At, 0, 1); GM_STAGE_B(GM_SB(0, 0), b2); GM_STAGE_B(GM_SB(0, 1), b2 + hstepB); GM_STAGE_A(GM_SA(0, 0), a2, o2[0]);
            GM_WAIT_V(8); GM_WAIT_L(0); GM_BAR; GM_MMA(1, 0, At, B0); GM_MMA(1, 1, At, B1); GM_BAR; GM_SCHED;
            GM_LDB(B0, 1, 0); GM_LDB(B1, 1, 1); GM_SCHED; GM_LDA(At, 1, 0); GM_STAGE_A(GM_SA(0, 1), a2 + hstepA, o2[1]);
            GM_WAIT_V(8); GM_WAIT_L(0); GM_BAR; GM_MMA(0, 0, At, B0); GM_MMA(0, 1, At, B1); GM_BAR; GM_SCHED;
            GM_LDA(At, 1, 1); GM_STAGE_B(GM_SB(1, 0), b3); GM_STAGE_B(GM_SB(1, 1), b3 + hstepB); GM_STAGE_A(GM_SA(1, 0), a3, o2[0]);
            GM_WAIT_V(8); GM_WAIT_L(0); GM_BAR; GM_MMA(1, 0, At, B0); GM_MMA(1, 1, At, B1); GM_BAR; GM_SCHED;
        }
        if (wr == 0) GM_BAR;
        if constexpr (MODE == 1) asm volatile("s_nop 7\n\ts_nop 7\n\ts_nop 7" ::: "memory");
        if constexpr (GPV & 8) { Unit uf_ = cur; uf_.pm = 0; E(acc, uf_, wr, wc, fr, fq); }
        else if constexpr (!(GPV & 1)) E(acc, cur, wr, wc, fr, fq);
        else { _Pragma("unroll") for (int a = 0; a < 2; ++a) _Pragma("unroll") for (int b = 0; b < 2; ++b) _Pragma("unroll") for (int m = 0; m < 4; ++m) asm volatile("" :: "v"(acc[a][b][m][0]), "v"(acc[a][b][m][1])); }
        if (!has_next) break;
#pragma unroll
        for (int a = 0; a < 2; ++a)
#pragma unroll
            for (int b = 0; b < 2; ++b)
#pragma unroll
                for (int m = 0; m < 4; ++m)
#pragma unroll
                    for (int n = 0; n < 2; ++n) acc[a][b][m][n] = (f32x4){0.f, 0.f, 0.f, 0.f};
        cur = nxt; cA = nA; cB = nB; ++ui;
        if constexpr (GATHER) {
#pragma unroll
            for (int h = 0; h < 2; ++h)
#pragma unroll
                for (int i = 0; i < 2; ++i) aoC[h][i] = aoN[h][i];
        }
        if (wr == 1) GM_BAR;
    }
    GM_WAIT_V(0);
    GM_BAR;
#undef GM_SA
#undef GM_SB
#undef GM_STAGE_A
#undef GM_STAGE_B
#undef GM_LDA
#undef GM_LDB
#undef GM_MMA
#undef GM_WAIT_V
#undef GM_WAIT_L
#undef GM_BAR
#undef GM_SCHED
}
}

typedef f32x4 Acc[2][2][4][2];
__device__ __forceinline__ u32x4 pack8(const f32x4 a, const f32x4 b) { u32x4 w; w.x = cvt_pk_bf16(a[0], a[1]); w.y = cvt_pk_bf16(a[2], a[3]); w.z = cvt_pk_bf16(b[0], b[1]); w.w = cvt_pk_bf16(b[2], b[3]); return w; }
__device__ __forceinline__ float silu_f(float g) { return g * __builtin_amdgcn_rcpf(1.0f + __builtin_amdgcn_exp2f(-g * LOG2E)); }

template <bool I8> __device__ __forceinline__ f32x4 accv(const f32x4& a) {
    if constexpr (I8) { const i32x4 i = __builtin_bit_cast(i32x4, a); return (f32x4){(float)i[0], (float)i[1], (float)i[2], (float)i[3]}; } else return a; }

struct SchedDense {
    const char* A; const char* B; unsigned lda, ldb; int nM, nN, nt, G, c;
    __device__ __forceinline__ bool next(int i, gm::Unit& u) const {
        int pm, pn; if (!gm::tile_order((long)i * G + c, nM, nN, pm, pn)) return false;
        u.pm = pm; u.pn = pn; u.nt = nt; u.aux = 0; u.rows = nullptr;
        u.A = A + (size_t)pm * 256 * lda; u.B = B + (size_t)pn * 256 * ldb; return true;
    }
};

__device__ __forceinline__ u32x4 tr8x8(u32x4 w, int fr) {
    const bool h4 = (fr & 4) != 0, h2 = (fr & 2) != 0, h1 = (fr & 1) != 0;
    { const unsigned s0 = h4 ? w[0] : w[2], s1 = h4 ? w[1] : w[3]; const unsigned r0 = __shfl_xor(s0, 4), r1 = __shfl_xor(s1, 4);
      if (h4) { w[0] = r0; w[1] = r1; } else { w[2] = r0; w[3] = r1; } }
    { const unsigned s0 = h2 ? w[0] : w[1], s1 = h2 ? w[2] : w[3]; const unsigned r0 = __shfl_xor(s0, 2), r1 = __shfl_xor(s1, 2);
      if (h2) { w[0] = r0; w[2] = r1; } else { w[1] = r0; w[3] = r1; } }
#pragma unroll
    for (int q = 0; q < 4; ++q) { const unsigned r = __shfl_xor(w[q], 1); w[q] = h1 ? ((r >> 16) | (w[q] & 0xffff0000u)) : ((w[q] & 0xffffu) | (r << 16)); }
    return w;
}
template <bool I8> struct EpiInProj {
    static constexpr bool PERM = true;
    unsigned char* pj; const float* rstd; const float* ropec; const float* ropes; const float* sa; const float* sb;
    __device__ __forceinline__ void operator()(const Acc& acc, const gm::Unit& u, int wr, int wc, int fr, int fq) const {
        int frl = fr, fql = fq; asm volatile("" : "+v"(frl), "+v"(fql));
        const int pn = u.pn, row0 = u.pm * 256 + wr * 64 + frl, cw = wc * 32 + 8 * fql;
        float rs[2][4];
#pragma unroll
        for (int ai = 0; ai < 2; ++ai)
#pragma unroll
            for (int m = 0; m < 4; ++m) { const int row = row0 + ai * 128 + m * 16; rs[ai][m] = I8 ? rstd[row] * sa[row] * sb[pn] : rstd[row]; }
#define AV(ai, bj, m, n) accv<I8>(acc[ai][bj][m][n])
        if (pn == 10) {
            bf16_t* ik = (bf16_t*)(pj + PJ_IK); float* iw = (float*)(pj + PJ_IW);
#pragma unroll
            for (int ai = 0; ai < 2; ++ai)
#pragma unroll
                for (int m = 0; m < 4; ++m) { const int row = row0 + ai * 128 + m * 16; const float r = rs[ai][m];
                    if (wc < 2) *(u32x4*)(ik + (size_t)row * 64 + cw) = pack8(AV(ai, 0, m, 0) * r, AV(ai, 0, m, 1) * r);
                    else if (wc == 2 && fq < 2) { *(f32x4*)(iw + (size_t)row * 16 + 8 * fq) = AV(ai, 0, m, 0) * r; *(f32x4*)(iw + (size_t)row * 16 + 8 * fq + 4) = AV(ai, 0, m, 1) * r; } }
            return;
        }
        if (pn >= 11 && pn < 19) {
            const bool isk = pn >= 15; const int h = isk ? pn - 15 : pn - 11; const size_t tile = (size_t)u.pm * 4 + h;
            const float lg2 = __builtin_log2f(1.0f - __builtin_exp2f(-5.0f - (float)h));
            bf16_t* qp = (bf16_t*)(pj + PJ_QP) + tile * 256 * 512; bf16_t* rk = (bf16_t*)(pj + PJ_RK) + h * 256; bf16_t* kt = (bf16_t*)(pj + PJ_KT) + tile * 256 * 256;
#pragma unroll
            for (int ai = 0; ai < 2; ++ai)
#pragma unroll
                for (int m = 0; m < 4; ++m) { const int row = row0 + ai * 128 + m * 16, pos = row & (SEQ - 1), i = row & 255;
                    const float r = rs[ai][m] * (isk ? 0.0625f * __builtin_amdgcn_exp2f(lg2 * (float)(255 - i)) : __builtin_amdgcn_exp2f(lg2 * (float)(i + 1)));
                    const f32x4 c0 = *(const f32x4*)(ropec + pos * 128 + cw), c1 = *(const f32x4*)(ropec + pos * 128 + cw + 4);
                    const f32x4 s0 = *(const f32x4*)(ropes + pos * 128 + cw), s1 = *(const f32x4*)(ropes + pos * 128 + cw + 4);
                    const f32x4 x10 = AV(ai, 0, m, 0) * r, x11 = AV(ai, 0, m, 1) * r, x20 = AV(ai, 1, m, 0) * r, x21 = AV(ai, 1, m, 1) * r;
                    const u32x4 w1 = pack8(x10 * c0 - x20 * s0, x11 * c1 - x21 * s1), w2 = pack8(x10 * s0 + x20 * c0, x11 * s1 + x21 * c1);
                    if (!isk) { bf16_t* rowp = qp + (size_t)i * 512 + cw; *(u32x4*)(rowp) = w1; *(u32x4*)(rowp + 128) = w2; }
                    else { bf16_t* rowp = rk + (size_t)row * 1024 + cw; *(u32x4*)(rowp) = w1; *(u32x4*)(rowp + 128) = w2;
                        bf16_t* tp = kt + (size_t)(cw + (frl & 7)) * 256 + (i - (frl & 7));
                        *(u32x4*)tp = tr8x8(w1, frl); *(u32x4*)(tp + 128 * 256) = tr8x8(w2, frl); }
                    asm volatile("" ::: "memory"); }
            return;
        }
        if (pn >= 19 && pn < 23) {
            const int h = pn - 19; const size_t tile = (size_t)u.pm * 4 + h; bf16_t* sv = (bf16_t*)(pj + PJ_SV) + tile * 256 * 512 + 256;
#pragma unroll
            for (int ai = 0; ai < 2; ++ai)
#pragma unroll
                for (int m = 0; m < 4; ++m) { const int row = row0 + ai * 128 + m * 16, i = row & 255; const float r = rs[ai][m];
#pragma unroll
                    for (int bj = 0; bj < 2; ++bj) { const u32x4 w = pack8(AV(ai, bj, m, 0) * r, AV(ai, bj, m, 1) * r);
                        *(u32x4*)(sv + (size_t)(bj * 128 + cw + (frl & 7)) * 512 + (i - (frl & 7))) = tr8x8(w, frl); }
                    asm volatile("" ::: "memory"); }
            return;
        }
        bf16_t* dst; int ld;
        if (pn < 4) { dst = (bf16_t*)(pj + PJ_Q) + pn * 256; ld = 1024; }
        else if (pn == 4) { dst = (bf16_t*)(pj + PJ_K); ld = 256; }
        else if (pn == 5) { dst = (bf16_t*)(pj + PJ_V); ld = 256; }
        else if (pn < 10) { dst = (bf16_t*)(pj + PJ_IQ) + (pn - 6) * 256; ld = 1024; }
        else { dst = (bf16_t*)(pj + PJ_RG) + (pn - 23) * 256; ld = 1024; }
#pragma unroll
        for (int ai = 0; ai < 2; ++ai)
#pragma unroll
            for (int m = 0; m < 4; ++m) { const int row = row0 + ai * 128 + m * 16; const float r = rs[ai][m]; bf16_t* rowp = dst + (size_t)row * ld + cw;
#pragma unroll
                for (int bj = 0; bj < 2; ++bj) *(u32x4*)(rowp + bj * 128) = pack8(AV(ai, bj, m, 0) * r, AV(ai, bj, m, 1) * r); }
    }
};
#undef AV

template <bool SRC32> struct EpiResid {
    static constexpr bool PERM = true;
    const float* src; bf16_t* hb; float sc;
    __device__ __forceinline__ void operator()(const Acc& acc, const gm::Unit& u, int wr, int wc, int fr, int fq) const {
        const int row0 = u.pm * 256 + wr * 64 + fr, col0 = u.pn * 256 + wc * 32 + 8 * fq;
#pragma unroll
        for (int ai = 0; ai < 2; ++ai)
#pragma unroll
            for (int m = 0; m < 4; ++m) { const size_t off = (size_t)(row0 + ai * 128 + m * 16) * DM + col0;
#pragma unroll
                for (int bj = 0; bj < 2; ++bj) { f32x4 b0, b1;
                    if constexpr (SRC32) { b0 = *(const f32x4*)(src + off + bj * 128); b1 = *(const f32x4*)(src + off + bj * 128 + 4); }
                    else { const u32x4 w = *(const u32x4*)(hb + off + bj * 128); b0 = (f32x4){bf_lo(w.x), bf_hi(w.x), bf_lo(w.y), bf_hi(w.y)}; b1 = (f32x4){bf_lo(w.z), bf_hi(w.z), bf_lo(w.w), bf_hi(w.w)}; }
                    *(u32x4*)(hb + off + bj * 128) = pack8(b0 + acc[ai][bj][m][0] * sc, b1 + acc[ai][bj][m][1] * sc); }
                asm volatile("" ::: "memory"); }
    }
};

template <bool I8> struct EpiFfnUp {
    static constexpr bool PERM = true;
    unsigned char* H; const float* rstd; const float* sa; const float* sb;
    __device__ __forceinline__ void operator()(const Acc& acc, const gm::Unit& u, int wr, int wc, int fr, int fq) const {
        const int row0 = u.pm * 256 + wr * 64 + fr, col0 = u.pn * 128 + wc * 32 + 8 * fq;
#pragma unroll
        for (int ai = 0; ai < 2; ++ai)
#pragma unroll
            for (int m = 0; m < 4; ++m) { const int row = row0 + ai * 128 + m * 16; const float r = I8 ? rstd[row] * sa[row] * sb[u.pn] : rstd[row]; f32x4 o[2]; const float ra = r * -LOG2E, c2 = r * r * S_H8;
#pragma unroll
                for (int n = 0; n < 2; ++n) { const f32x4 g4 = accv<I8>(acc[ai][0][m][n]), u4 = accv<I8>(acc[ai][1][m][n]);
#pragma unroll
                    for (int h2 = 0; h2 < 2; ++h2) { const f32x2 g = {g4[2 * h2], g4[2 * h2 + 1]}, u = {u4[2 * h2], u4[2 * h2 + 1]};
                        const f32x2 a = g * (f32x2){ra, ra}; f32x2 e = {__builtin_amdgcn_exp2f(a[0]), __builtin_amdgcn_exp2f(a[1])}; e = e + (f32x2){1.0f, 1.0f};
                        const f32x2 d = {__builtin_amdgcn_rcpf(e[0]), __builtin_amdgcn_rcpf(e[1])}; const f32x2 r2 = (g * u) * ((f32x2){c2, c2} * d);
                        o[n][2 * h2] = r2[0]; o[n][2 * h2 + 1] = r2[1]; } }
                u32x2 w; w.x = cvt_pk4_fp8c(o[0][0], o[0][1], o[0][2], o[0][3]); w.y = cvt_pk4_fp8c(o[1][0], o[1][1], o[1][2], o[1][3]);
                *(u32x2*)(H + (size_t)row * DFF + col0) = w; asm volatile("" ::: "memory"); }
    }
};

struct SchedRetTile {
    const char* A; const char* B; size_t strideA, strideB; int nt, G, c, bstep_row;
    __device__ __forceinline__ bool next(int i, gm::Unit& u) const {
        const int L = i * G + c; if (L >= 256) return false;
        u.pm = L >> 2; u.pn = 0; u.nt = nt; u.aux = L; u.rows = nullptr;
        u.A = A + (size_t)L * strideA; u.B = bstep_row ? B + (size_t)(L >> 2) * bstep_row + (size_t)(L & 3) * 512 : B + (size_t)L * strideB; return true;
    }
};
struct EpiRetP {
    static constexpr bool PERM = true;
    bf16_t* QP;
    __device__ __forceinline__ void operator()(const Acc& acc, const gm::Unit& u, int wr, int wc, int fr, int fq) const {
        const int h = u.aux & 3; const float gi = __builtin_amdgcn_exp2f(-256.0f * __builtin_log2f(1.0f - __builtin_exp2f(-5.0f - (float)h)));
        bf16_t* Pb = QP + (size_t)u.aux * 256 * 512 + 256;
        int t0 = wr * 64 + fr; const int s0 = wc * 32 + 8 * fq; asm volatile("" : "+v"(t0));
#pragma unroll
        for (int ai = 0; ai < 2; ++ai)
#pragma unroll
            for (int m = 0; m < 4; ++m) { const int t = t0 + ai * 128 + m * 16;
#pragma unroll
                for (int bj = 0; bj < 2; ++bj) { const int d0 = t - (s0 + bj * 128); f32x4 o[2];
#pragma unroll
                    for (int n = 0; n < 2; ++n)
#pragma unroll
                        for (int e = 0; e < 4; ++e) o[n][e] = (d0 - (4 * n + e) >= 0) ? acc[ai][bj][m][n][e] * gi : 0.f;
                    *(u32x4*)(Pb + (size_t)t * 512 + s0 + bj * 128) = pack8(o[0], o[1]); }
                asm volatile("" ::: "memory"); }
    }
};
struct EpiRetKV {
    static constexpr bool PERM = false;
    float* KVT;
    __device__ __forceinline__ void operator()(const Acc& acc, const gm::Unit& u, int wr, int wc, int fr, int fq) const {
        float* base = KVT + (size_t)u.aux * 65536; const int row0 = wr * 64 + fr, col0 = wc * 32 + 4 * fq;
#pragma unroll
        for (int ai = 0; ai < 2; ++ai)
#pragma unroll
            for (int m = 0; m < 4; ++m) { float* rowp = base + (size_t)(row0 + ai * 128 + m * 16) * 256 + col0;
#pragma unroll
                for (int bj = 0; bj < 2; ++bj)
#pragma unroll
                    for (int n = 0; n < 2; ++n) *(f32x4*)(rowp + bj * 128 + n * 16) = acc[ai][bj][m][n];
                asm volatile("" ::: "memory"); }
    }
};
struct EpiRetOut {
    static constexpr bool PERM = true;
    unsigned char* mix; const bf16_t* rg; const float* gn; LAS unsigned char* xl;
    __device__ __forceinline__ void operator()(const Acc& acc, const gm::Unit& u, int wr, int wc, int fr, int fq) const {
        const int tile = u.aux, h = tile & 3; LAS f32x2* P = (LAS f32x2*)xl;
        const int lr0 = wr * 64 + fr;
#pragma unroll
        for (int ai = 0; ai < 2; ++ai)
#pragma unroll
            for (int m = 0; m < 4; ++m) { float s1 = 0.f, s2 = 0.f;
#pragma unroll
                for (int bj = 0; bj < 2; ++bj)
#pragma unroll
                    for (int n = 0; n < 2; ++n) { const f32x4 x = acc[ai][bj][m][n]; s1 += (x[0] + x[1]) + (x[2] + x[3]); s2 += (x[0] * x[0] + x[1] * x[1]) + (x[2] * x[2] + x[3] * x[3]); }
                s1 += __shfl_xor(s1, 16); s1 += __shfl_xor(s1, 32); s2 += __shfl_xor(s2, 16); s2 += __shfl_xor(s2, 32);
                if (fq == 0) P[(lr0 + ai * 128 + m * 16) * 4 + wc] = (f32x2){s1, s2}; }
        asm volatile("s_waitcnt lgkmcnt(0)" ::: "memory"); __builtin_amdgcn_s_barrier(); asm volatile("" ::: "memory");
        const size_t grow0 = (size_t)(tile >> 2) * 256; const int cw = wc * 32 + 8 * fq;
#pragma unroll
        for (int ai = 0; ai < 2; ++ai)
#pragma unroll
            for (int m = 0; m < 4; ++m) { const int lr = lr0 + ai * 128 + m * 16;
                const f32x4 pa = *(const LAS f32x4*)(P + lr * 4), pb = *(const LAS f32x4*)(P + lr * 4 + 2);
                const float S = (pa[0] + pa[2]) + (pb[0] + pb[2]), Q = (pa[1] + pa[3]) + (pb[1] + pb[3]);
                const float mu = S * (1.0f / RD), var = Q * (1.0f / RD) - mu * mu, r = 1.0f / sqrtf(fmaxf(var, 0.f) + GN_EPS);
                const size_t goff = (grow0 + lr) * 1024 + h * 256 + cw;
#pragma unroll
                for (int bj = 0; bj < 2; ++bj) { const u32x4 gw = *(const u32x4*)(rg + goff + bj * 128);
                    const f32x4 g0 = *(const f32x4*)(gn + h * 256 + bj * 128 + cw), g1 = *(const f32x4*)(gn + h * 256 + bj * 128 + cw + 4);
                    f32x4 o0, o1;
#pragma unroll
                    for (int e = 0; e < 4; ++e) { const float ga = (e & 1) ? bf_hi(gw[e >> 1]) : bf_lo(gw[e >> 1]), gb = (e & 1) ? bf_hi(gw[2 + (e >> 1)]) : bf_lo(gw[2 + (e >> 1)]);
                        o0[e] = silu_f(ga) * (acc[ai][bj][m][0][e] - mu) * (r * S_MIX8) * g0[e]; o1[e] = silu_f(gb) * (acc[ai][bj][m][1][e] - mu) * (r * S_MIX8) * g1[e]; }
                    u32x2 w; w.x = cvt_pk4_fp8(o0[0], o0[1], o0[2], o0[3]); w.y = cvt_pk4_fp8(o1[0], o1[1], o1[2], o1[3]);
                    *(u32x2*)(mix + (grow0 + lr) * DM + 1024 + h * 256 + bj * 128 + cw) = w; }
                asm volatile("" ::: "memory"); }
    }
};

struct MoeInfo { int toff[NE + 1]; };
__device__ __forceinline__ MoeInfo moe_info(const unsigned* ctl) {
    MoeInfo mi; int t = 0;
#pragma unroll
    for (int e = 0; e < NE; ++e) { mi.toff[e] = t; const int c = (int)__builtin_amdgcn_readfirstlane((int)ctl[CW_CNT + 64 * e]); t += (c + 255) >> 8; }
    mi.toff[NE] = t; return mi;
}
__device__ __forceinline__ int moe_expert(const MoeInfo& mi, int pm, int& lt) { int e = 0; lt = pm;
#pragma unroll
    for (int j = 1; j < NE; ++j) { const bool ge = pm >= mi.toff[j]; e += ge ? 1 : 0; lt = ge ? pm - mi.toff[j] : lt; }
    return e; }
struct SchedMoeUp {
    MoeInfo mi; const char* hb; const char* W; const int* list; int G, c;
    __device__ __forceinline__ bool next(int i, gm::Unit& u) const {
        int pm, pn; if (!gm::tile_order((long)i * G + c, mi.toff[NE], DFE / 128, pm, pn)) return false;
        int lt; const int e = moe_expert(mi, pm, lt);
        u.pm = pm; u.pn = pn; u.nt = DM / 128; u.aux = e; u.rows = list + e * NTOK + lt * 256;
        u.A = hb; u.B = W + ((size_t)e * (2 * DFE) + pn * 256) * DM; return true;
    }
};
struct EpiMoeUp {
    static constexpr bool PERM = true;
    unsigned char* H; const float* rfac; const int* list;
    __device__ __forceinline__ void operator()(const Acc& acc, const gm::Unit& u, int wr, int wc, int fr, int fq) const {
        const int lr0 = wr * 64 + fr, col0 = u.pn * 128 + wc * 32 + 8 * fq; const float* rf = rfac + (u.rows - list);
#pragma unroll
        for (int ai = 0; ai < 2; ++ai)
#pragma unroll
            for (int m = 0; m < 4; ++m) { const int lr = lr0 + ai * 128 + m * 16; const float r = rf[lr] * (1.0f / (S_HB8 * S_WUP8)); f32x4 o[2];
                const float ra = r * -LOG2E, c2 = r * r * S_H8;
#pragma unroll
                for (int n = 0; n < 2; ++n)
#pragma unroll
                    for (int h2 = 0; h2 < 2; ++h2) {
                        const f32x2 g = {acc[ai][0][m][n][2 * h2], acc[ai][0][m][n][2 * h2 + 1]}, u = {acc[ai][1][m][n][2 * h2], acc[ai][1][m][n][2 * h2 + 1]};
                        const f32x2 a = g * (f32x2){ra, ra}; f32x2 e = {__builtin_amdgcn_exp2f(a[0]), __builtin_amdgcn_exp2f(a[1])}; e = e + (f32x2){1.0f, 1.0f};
                        const f32x2 d = {__builtin_amdgcn_rcpf(e[0]), __builtin_amdgcn_rcpf(e[1])}; const f32x2 r2 = (g * u) * ((f32x2){c2, c2} * d);
                        o[n][2 * h2] = r2[0]; o[n][2 * h2 + 1] = r2[1]; }
                u32x2 w; w.x = cvt_pk4_fp8c(o[0][0], o[0][1], o[0][2], o[0][3]); w.y = cvt_pk4_fp8c(o[1][0], o[1][1], o[1][2], o[1][3]);
                *(u32x2*)(H + (size_t)(u.pm * 256 + lr) * DFE + col0) = w; asm volatile("" ::: "memory"); }
    }
};
struct SchedMoeDown {
    MoeInfo mi; const char* H; const char* W; int G, c;
    __device__ __forceinline__ bool next(int i, gm::Unit& u) const {
        int pm, pn; if (!gm::tile_order((long)i * G + c, mi.toff[NE], DM / 256, pm, pn)) return false;
        int lt; const int e = moe_expert(mi, pm, lt);
        u.pm = pm; u.pn = pn; u.nt = DFE / 128; u.aux = e; u.rows = nullptr;
        u.A = H + (size_t)pm * 256 * DFE; u.B = W + ((size_t)e * DM + pn * 256) * DFE; return true;
    }
};
struct EpiMoeDown {
    static constexpr bool PERM = true;
    bf16_t* Y;
    __device__ __forceinline__ void operator()(const Acc& acc, const gm::Unit& u, int wr, int wc, int fr, int fq) const {
        const int row0 = u.pm * 256 + wr * 64 + fr, col0 = u.pn * 256 + wc * 32 + 8 * fq;
#pragma unroll
        for (int ai = 0; ai < 2; ++ai)
#pragma unroll
            for (int m = 0; m < 4; ++m) { bf16_t* rowp = Y + (size_t)(row0 + ai * 128 + m * 16) * DM + col0;
#pragma unroll
                for (int bj = 0; bj < 2; ++bj) *(u32x4*)(rowp + bj * 128) = pack8(acc[ai][bj][m][0] * (1.0f / (S_H8 * S_WDN8)), acc[ai][bj][m][1] * (1.0f / (S_H8 * S_WDN8))); }
    }
};

struct Args { const float* in[16]; float* out; unsigned char* ws; int ph_lo, ph_hi, use_bar, pad; };
typedef const __attribute__((address_space(4))) Args* KArgs;
__device__ __forceinline__ KArgs kargs() { KArgs p = (KArgs)__builtin_amdgcn_kernarg_segment_ptr(); asm volatile("" : "+s"(p)); return p; }
#define KIN(i) (as_global((const float*)kargs()->in[i]))
#define KOUT (as_global((float*)kargs()->out))
struct Ctx {
    LAS unsigned char* lds;
    unsigned char* ws; unsigned* ctl;
    int wave, G, gw, NGW, bx;
};


template <int OUT>
__device__ __forceinline__ void conv_item(const float* src0, const float* src1, int Nsrc, const float* gain, void* dstv, int Kdim, int mode, int d0, int k0, LAS float* scr, int lane, float wscale) {
    constexpr bool F8 = OUT == 1;
    const int d = d0 + lane; const float* src = src0; int col = d; bool valid = true;
    if (mode == 1) { if (d >= 2816) col = d - 176; else if (d >= 2560) valid = (d - 2560) < 80; }
    else if (mode == 2) { const int t = d >> 8, bj = (d >> 7) & 1, cc = d & 127; src = bj ? src1 : src0; col = 128 * t + cc; }
    const float* p = src + (size_t)k0 * Nsrc + col;
    float vv[64];
#pragma unroll
    for (int kk = 0; kk < 64; ++kk) vv[kk] = valid ? p[(size_t)kk * Nsrc] : 0.f;
    float qs = 1.f;
    if constexpr (OUT == 2) qs = wscale;
#pragma unroll
    for (int k16 = 0; k16 < 4; ++k16) {
#pragma unroll
        for (int k2 = 0; k2 < 16; ++k2) { const int kk = 16 * k16 + k2; float v = vv[kk]; if (gain) v *= gain[k0 + kk]; if (F8) v *= wscale; if (OUT == 2) v *= qs; scr[kk * 65 + lane] = v; }
        asm volatile("" ::: "memory"); }
    LDS_WAIT(); asm volatile("" ::: "memory");
    const int c = lane & 7;
#pragma unroll
    for (int j = 0; j < 8; ++j) { const int n = (lane >> 3) + 8 * j; const LAS float* s = scr + (8 * c) * 65 + n;
        if constexpr (OUT == 2) { u32x2 o; o.x = pk4_i8(s[0 * 65], s[1 * 65], s[2 * 65], s[3 * 65]); o.y = pk4_i8(s[4 * 65], s[5 * 65], s[6 * 65], s[7 * 65]);
            *(u32x2*)((unsigned char*)dstv + (size_t)(d0 + n) * Kdim + k0 + 8 * c) = o; }
        else if constexpr (F8) { u32x2 o; o.x = cvt_pk4_fp8c(s[0 * 65], s[1 * 65], s[2 * 65], s[3 * 65]); o.y = cvt_pk4_fp8c(s[4 * 65], s[5 * 65], s[6 * 65], s[7 * 65]);
            *(u32x2*)((unsigned char*)dstv + (size_t)(d0 + n) * Kdim + k0 + 8 * c) = o; }
        else { u32x4 o; o.x = cvt_pk_bf16(s[0 * 65], s[1 * 65]); o.y = cvt_pk_bf16(s[2 * 65], s[3 * 65]); o.z = cvt_pk_bf16(s[4 * 65], s[5 * 65]); o.w = cvt_pk_bf16(s[6 * 65], s[7 * 65]);
            *(u32x4*)((bf16_t*)dstv + (size_t)(d0 + n) * Kdim + k0 + 8 * c) = o; } }
    LDS_WAIT(); asm volatile("" ::: "memory");
}
template <int OUT = 0>
__device__ __forceinline__ void conv_job(int lane, int r, const float* s0, const float* s1, int Nsrc, const float* gain, void* dst, int Kdim, int Ndst, int mode, LAS float* scr, float wscale = 1.f) {
    const int ndb = Ndst / 64, kb = r / ndb, db = r % ndb;
    conv_item<OUT>(s0, s1, Nsrc, gain, dst, Kdim, mode, db * 64, kb * 64, scr, lane, wscale);
}
__device__ __forceinline__ float wmax_item(const float* src0, const float* src1, int Nsrc, const float* gain, int mode, int d0, int k0, int lane) {
    const int d = d0 + lane; const float* src = src0; int col = d; bool valid = true;
    if (mode == 1) { if (d >= 2816) col = d - 176; else if (d >= 2560) valid = (d - 2560) < 80; }
    else if (mode == 2) { const int t = d >> 8, bj = (d >> 7) & 1, cc = d & 127; src = bj ? src1 : src0; col = 128 * t + cc; }
    const float* p = src + (size_t)k0 * Nsrc + col; float mx = 0.f;
    if (valid) {
#pragma unroll 1
        for (int k64 = 0; k64 < 256; k64 += 64) { float t[64];
#pragma unroll
            for (int kk = 0; kk < 64; ++kk) t[kk] = p[(size_t)(k64 + kk) * Nsrc];
#pragma unroll
            for (int k16 = 0; k16 < 4; ++k16) {
#pragma unroll
                for (int k2 = 0; k2 < 16; ++k2) mx = fmaxf(mx, fabsf(t[16 * k16 + k2] * gain[k0 + k64 + 16 * k16 + k2]));
                asm volatile("" ::: "memory"); } } }
#pragma unroll
    for (int o2 = 1; o2 < 64; o2 <<= 1) mx = fmaxf(mx, __shfl_xor(mx, o2));
    return mx;
}
template <int KIND>
__device__ __forceinline__ void i8_tile(Ctx& C, int t, unsigned char* wsl, LAS float* scr, int lane) {
    constexpr int Nsrc = KIND == 0 ? INW : DFF, mode = KIND == 0 ? 1 : 2;
    const int l = KIND == 0 ? t / (INP / 256) : 0, pn = KIND == 0 ? t % (INP / 256) : t;
    const float* s0 = KIND == 0 ? KIN(3) + (size_t)l * DM * INW : KIN(9); const float* s1 = KIND == 0 ? nullptr : KIN(10); const float* gain = KIND == 0 ? KIN(2) + l * DM : KIN(8);
    unsigned char* dst = KIND == 0 ? (unsigned char*)(wsl + WS_W_IN) + (size_t)l * INP * DM : (unsigned char*)(wsl + WS_W_FUP);
    float* sb = KIND == 0 ? (float*)(wsl + WS_SMALL + SM_SBIN) + l * (INP / 256) + pn : (float*)(wsl + WS_SMALL + SM_SBF) + pn;
    LAS float* red = (LAS float*)(C.lds + 8 * 16896);
    float mx = 0.f;
#pragma unroll 1
    for (int cg = 0; cg < 4; ++cg) mx = fmaxf(mx, wmax_item(s0, s1, Nsrc, gain, mode, pn * 256 + cg * 64, C.wave * 256, lane));
    if (lane == 0) red[C.wave] = mx;
    __syncthreads();
    float tm = 0.f;
#pragma unroll
    for (int w = 0; w < 8; ++w) tm = fmaxf(tm, red[w]);
    const float qs = tm > 0.f ? 127.0f / tm : 0.f;
    if (C.wave == 0 && lane == 0) *sb = tm * (1.0f / 127.0f);
#pragma unroll 1
    for (int it = C.wave; it < 4 * (DM / 64); it += 8) { const int cg = it & 3, kb = it >> 2;
        conv_item<2>(s0, s1, Nsrc, gain, dst, DM, mode, pn * 256 + cg * 64, kb * 64, scr, lane, qs); }
    __syncthreads();
}
__device__ __forceinline__ void phase_prepA(Ctx& C) {
    const int tidl = tid_l(), lane = tidl & 63; (void)lane;
    unsigned char* const wsl = launder(C.ws); unsigned* const ctll = (unsigned*)(wsl + WS_CTL);
    LAS float* scr = (LAS float*)(C.lds + C.wave * 16896);
    constexpr int I_OUT = (DM / 64) * (DM / 64), I_FDN = (DM / 64) * (DFF / 64), I_MUP = (2 * DFE / 64) * (DM / 64), I_MDN = (DM / 64) * (DFE / 64);
    constexpr int NTILE8 = 2 * (INP / 256) + 2 * DFF / 256;
    for (int t = C.bx; t < NTILE8; t += C.G) { if (t < 2 * (INP / 256)) i8_tile<0>(C, t, wsl, scr, lane); else i8_tile<1>(C, t - 2 * (INP / 256), wsl, scr, lane); }
    for (int r = C.gw; r < 2 * I_OUT; r += C.NGW) { const int l = r / I_OUT;
        conv_job<1>(lane, r - l * I_OUT, KIN(7) + (size_t)l * DM * DM, nullptr, DM, nullptr, (unsigned char*)(wsl + WS_W_OUT) + (size_t)l * DM * DM, DM, DM, 0, scr, S_WOUT8); }
    for (int r = C.gw; r < I_FDN; r += C.NGW) conv_job<1>(lane, r, KIN(11), nullptr, DM, nullptr, (unsigned char*)(wsl + WS_W_FDN), DFF, DM, 0, scr, S_WDN8);
    for (;;) { int itb = 0; if (lane == 0) itb = (int)atomicAdd(ctll + CW_QUEUE, 8u); itb = __builtin_amdgcn_readfirstlane(itb);
        if (itb >= NE * I_MUP + NE * I_MDN) break;
#pragma unroll 1
      for (int it = itb; it < itb + 8 && it < NE * I_MUP + NE * I_MDN; ++it) {
        if (it < NE * I_MUP) { const int e = it / I_MUP;
            conv_job<1>(lane, it - e * I_MUP, KIN(13) + (size_t)e * DM * DFE, KIN(14) + (size_t)e * DM * DFE, DFE, KIN(8) + DM, (unsigned char*)(wsl + WS_W_MUP) + (size_t)e * 2 * DFE * DM, DM, 2 * DFE, 2, scr, S_WUP8); }
        else { const int r = it - NE * I_MUP, e = r / I_MDN;
            conv_job<1>(lane, r - e * I_MDN, KIN(15) + (size_t)e * DFE * DM, nullptr, DM, nullptr, (unsigned char*)(wsl + WS_W_MDN) + (size_t)e * DM * DFE, DFE, DM, 0, scr, S_WDN8); } } }
    float* rc = (float*)(wsl + WS_ROPE); float* rsn = rc + SEQ * 128;
    for (int i = C.gw * 64 + lane; i < SEQ * 128; i += C.NGW * 64) { const int pos = i >> 7, j = i & 127;
        const float inv = (float)pow(10000.0, -(double)j / 128.0); const float ang = (float)pos * inv; double sn, cs; sincos((double)ang, &sn, &cs); rc[i] = (float)cs; rsn[i] = (float)sn; }
    int* list = (int*)(wsl + WS_SMALL + SM_LIST);
    float* rfac = (float*)(wsl + WS_SMALL + SM_RFAC);
    for (int i = C.gw * 64 + lane; i < NE * NTOK; i += C.NGW * 64) { list[i] = 0; rfac[i] = 0.f; }
}

template <bool ROUTER>
__device__ __forceinline__ void phase_stats(Ctx& C, const float* h, int layer) {
    const int tidl = tid_l(), lane = tidl & 63; (void)lane;
    unsigned char* const wsl = launder(C.ws); unsigned* const ctll = (unsigned*)(wsl + WS_CTL); (void)ctll;
    bf16_t* hb = (bf16_t*)(wsl + WS_HB); float* rstd = (float*)(wsl + WS_SMALL + SM_RSTD);
    const float* gain = KIN(8) + layer * DM; const float* wr = KIN(12);
    for (int row = C.gw; row < NTOK; row += C.NGW) {
        f32x4 v[8]; float ss = 0.f;
#pragma unroll
        for (int j = 0; j < 8; ++j) {
            if constexpr (ROUTER) { const u32x2 w = ((const u32x2*)(hb + (size_t)row * DM) + lane)[64 * j]; v[j] = (f32x4){bf_lo(w.x), bf_hi(w.x), bf_lo(w.y), bf_hi(w.y)}; }
            else v[j] = ((const f32x4*)(h + (size_t)row * DM) + lane)[64 * j];
            ss += (v[j][0] * v[j][0] + v[j][1] * v[j][1]) + (v[j][2] * v[j][2] + v[j][3] * v[j][3]); }
        ss = wave_sum(ss); const float r = 1.0f / sqrtf(ss * (1.0f / DM) + EPS);
        if (lane == 0) rstd[row] = r;
        if constexpr (!ROUTER) {
            float mx = 0.f;
#pragma unroll
            for (int j = 0; j < 8; ++j) mx = fmaxf(fmaxf(mx, fmaxf(fabsf(v[j][0]), fabsf(v[j][1]))), fmaxf(fabsf(v[j][2]), fabsf(v[j][3])));
#pragma unroll
            for (int o2 = 1; o2 < 64; o2 <<= 1) mx = fmaxf(mx, __shfl_xor(mx, o2));
            const float q = mx > 0.f ? 127.0f / mx : 0.f;
            if (lane == 0) ((float*)(wsl + WS_SMALL + SM_SA))[row] = mx * (1.0f / 127.0f);
            unsigned* o8 = (unsigned*)(wsl + WS_HB8 + (size_t)row * DM) + lane;
#pragma unroll
            for (int j = 0; j < 8; ++j) o8[64 * j] = pk4_i8(v[j][0] * q, v[j][1] * q, v[j][2] * q, v[j][3] * q);
        } else {
            unsigned* o8 = (unsigned*)(wsl + WS_HB8 + (size_t)row * DM) + lane;
#pragma unroll
            for (int j = 0; j < 8; ++j) o8[64 * j] = cvt_pk4_fp8c(v[j][0] * S_HB8, v[j][1] * S_HB8, v[j][2] * S_HB8, v[j][3] * S_HB8);
        }
        if constexpr (ROUTER) {
            float lg[NE];
#pragma unroll
            for (int e = 0; e < NE; ++e) lg[e] = 0.f;
#pragma unroll
            for (int j = 0; j < 8; ++j) { const int k0 = 4 * lane + 256 * j; const f32x4 g4 = *(const f32x4*)(gain + k0);
#pragma unroll
                for (int q = 0; q < 4; ++q) { const float x = v[j][q] * g4[q]; const f32x4 w0 = *(const f32x4*)(wr + (size_t)(k0 + q) * NE), w1 = *(const f32x4*)(wr + (size_t)(k0 + q) * NE + 4);
                    lg[0] += x * w0[0]; lg[1] += x * w0[1]; lg[2] += x * w0[2]; lg[3] += x * w0[3]; lg[4] += x * w1[0]; lg[5] += x * w1[1]; lg[6] += x * w1[2]; lg[7] += x * w1[3]; } }
#pragma unroll
            for (int e = 0; e < NE; ++e) lg[e] = wave_sum(lg[e]) * r;
            int i1 = 0; float v1 = lg[0];
#pragma unroll
            for (int e = 1; e < NE; ++e) if (lg[e] > v1) { v1 = lg[e]; i1 = e; }
            int i2 = -1; float v2 = -3.0e38f;
#pragma unroll
            for (int e = 0; e < NE; ++e) if (e != i1 && lg[e] > v2) { v2 = lg[e]; i2 = e; }
            const float g1 = 1.0f / (1.0f + __expf(v2 - v1)), g2 = 1.0f - g1;
            if (lane == 0) {
                const int s1 = (int)atomicAdd(ctll + CW_CNT + 64 * i1, 1u), s2 = (int)atomicAdd(ctll + CW_CNT + 64 * i2, 1u);
                int* list = (int*)(wsl + WS_SMALL + SM_LIST); list[i1 * NTOK + s1] = row; list[i2 * NTOK + s2] = row;
                float* rfac = (float*)(wsl + WS_SMALL + SM_RFAC); rfac[i1 * NTOK + s1] = r; rfac[i2 * NTOK + s2] = r;
                int* te = (int*)(wsl + WS_SMALL + SM_TOKE); int* ts = (int*)(wsl + WS_SMALL + SM_TOKS); float* tg = (float*)(wsl + WS_SMALL + SM_TOKG);
                te[2 * row] = i1; te[2 * row + 1] = i2; ts[2 * row] = s1; ts[2 * row + 1] = s2; tg[2 * row] = g1; tg[2 * row + 1] = g2;
            }
        }
    }
}

__device__ __forceinline__ void phase_rstd(Ctx& C) {
    const int tidl = tid_l(), lane = tidl & 63;
    unsigned char* const wsl = launder(C.ws);
    const bf16_t* hb = (const bf16_t*)(wsl + WS_HB); float* rstd = (float*)(wsl + WS_SMALL + SM_RSTD); float* sa = (float*)(wsl + WS_SMALL + SM_SA);
    for (int row = C.gw; row < NTOK; row += C.NGW) {
        const u32x4* p = (const u32x4*)(hb + (size_t)row * DM) + lane; float ss = 0.f, mx = 0.f; u32x4 w[4];
#pragma unroll
        for (int j = 0; j < 4; ++j) { w[j] = p[64 * j];
#pragma unroll
            for (int q = 0; q < 4; ++q) { const float a = bf_lo(w[j][q]), b = bf_hi(w[j][q]); ss += a * a + b * b; mx = fmaxf(mx, fmaxf(fabsf(a), fabsf(b))); } }
        ss = wave_sum(ss);
#pragma unroll
        for (int o2 = 1; o2 < 64; o2 <<= 1) mx = fmaxf(mx, __shfl_xor(mx, o2));
        const float qq = mx > 0.f ? 127.0f / mx : 0.f;
        if (lane == 0) { rstd[row] = 1.0f / sqrtf(ss * (1.0f / DM) + EPS); sa[row] = mx * (1.0f / 127.0f); }
        u32x2* o8 = (u32x2*)(wsl + WS_HB8 + (size_t)row * DM) + lane;
#pragma unroll
        for (int j = 0; j < 4; ++j) { u32x2 o; o.x = pk4_i8(bf_lo(w[j][0]) * qq, bf_hi(w[j][0]) * qq, bf_lo(w[j][1]) * qq, bf_hi(w[j][1]) * qq);
            o.y = pk4_i8(bf_lo(w[j][2]) * qq, bf_hi(w[j][2]) * qq, bf_lo(w[j][3]) * qq, bf_hi(w[j][3]) * qq); o8[64 * j] = o; }
    }
}

__device__ __forceinline__ void phase_post(Ctx& C, int layer) {
    const int tidl = tid_l(), lane = tidl & 63; (void)lane;
    unsigned char* const wsl = launder(C.ws); unsigned* const ctll = (unsigned*)(wsl + WS_CTL); (void)ctll;
    bf16_t* q = (bf16_t*)(wsl + WS_PROJ + PJ_Q); bf16_t* k = (bf16_t*)(wsl + WS_PROJ + PJ_K);
    const float* qg = KIN(4) + layer * AD; const float* kg = KIN(5) + layer * AD;
    const float qsc = 0.088388347648318440f * LOG2E;
    const f32x2 qg2 = *(const f32x2*)(qg + 2 * lane), kg2 = *(const f32x2*)(kg + 2 * lane);
    for (int row0 = C.gw; row0 < NTOK; row0 += 4 * C.NGW) {
        unsigned w[4][10];
#pragma unroll
        for (int j = 0; j < 4; ++j) { const int row = row0 + j * C.NGW; if (row < NTOK) { const unsigned* qr = (const unsigned*)(q + (size_t)row * 1024) + lane; const unsigned* kr = (const unsigned*)(k + (size_t)row * 256) + lane;
#pragma unroll
            for (int hh = 0; hh < 8; ++hh) w[j][hh] = qr[64 * hh];
            w[j][8] = kr[0]; w[j][9] = kr[64]; } }
#pragma unroll
        for (int j = 0; j < 4; ++j) { const int row = row0 + j * C.NGW; if (row < NTOK) { unsigned* qr = (unsigned*)(q + (size_t)row * 1024) + lane; unsigned* kr = (unsigned*)(k + (size_t)row * 256) + lane;
#pragma unroll
            for (int hh = 0; hh < 10; ++hh) { const float a = bf_lo(w[j][hh]), b = bf_hi(w[j][hh]); const float ss = wave_sum(a * a + b * b); const float r = 1.0f / sqrtf(ss * (1.0f / AD) + EPS);
                if (hh < 8) qr[64 * hh] = cvt_pk_bf16(a * r * qg2[0] * qsc, b * r * qg2[1] * qsc); else kr[64 * (hh - 8)] = cvt_pk_bf16(a * r * kg2[0], b * r * kg2[1]); } } }
    }
}

__device__ __forceinline__ void phase_retscan(Ctx& C) {
    const int tidl = tid_l(), lane = tidl & 63;
    unsigned char* const wsl = launder(C.ws);
    const float* KVT = (const float*)(wsl + WS_PROJ + PJ_KVT); bf16_t* SV = (bf16_t*)(wsl + WS_PROJ + PJ_SV);
    for (int idx = C.gw * 64 + lane; idx < 16 * 256 * 64; idx += C.NGW * 64) {
        const int bh = idx >> 14, e = (idx >> 6) & 255, d4 = idx & 63, b = bh >> 2, h = bh & 3;
        const float g256 = __builtin_amdgcn_exp2f(256.0f * __builtin_log2f(1.0f - __builtin_exp2f(-5.0f - (float)h)));
        f32x4 S = {0.f, 0.f, 0.f, 0.f};
#pragma unroll 4
        for (int n = 0; n < 16; ++n) { const size_t tile = (size_t)(b * 16 + n) * 4 + h;
            u32x2 w; w.x = cvt_pk_bf16(S[0], S[1]); w.y = cvt_pk_bf16(S[2], S[3]);
            *(u32x2*)(SV + (tile * 256 + e) * 512 + 4 * d4) = w;
            if (n < 15) { const f32x4 kv = *(const f32x4*)(KVT + tile * 65536 + (size_t)e * 256 + 4 * d4); S = S * g256 + kv; } }
    }
}

__device__ __forceinline__ void phase_combine(Ctx& C) {
    const int tidl = tid_l(), lane = tidl & 63; (void)lane;
    unsigned char* const wsl = launder(C.ws); unsigned* const ctll = (unsigned*)(wsl + WS_CTL); (void)ctll;
    const MoeInfo mi = moe_info(ctll);
    const bf16_t* Y = (const bf16_t*)(wsl + WS_PROJ + PJ_Y); const bf16_t* hbp = (const bf16_t*)(wsl + WS_HB);
    const int* te = (const int*)(wsl + WS_SMALL + SM_TOKE); const int* ts = (const int*)(wsl + WS_SMALL + SM_TOKS); const float* tg = (const float*)(wsl + WS_SMALL + SM_TOKG);
    for (int row = C.gw; row < NTOK; row += C.NGW) {
        const int e1 = te[2 * row], e2 = te[2 * row + 1]; const float g1 = tg[2 * row], g2 = tg[2 * row + 1];
        int t1 = 0, t2 = 0;
#pragma unroll
        for (int e = 0; e < NE; ++e) { t1 = (e == e1) ? mi.toff[e] : t1; t2 = (e == e2) ? mi.toff[e] : t2; }
        const size_t p1 = (size_t)t1 * 256 + ts[2 * row], p2 = (size_t)t2 * 256 + ts[2 * row + 1];
#pragma unroll
        for (int j = 0; j < 4; ++j) { const int c = 8 * lane + 512 * j;
            const u32x4 a = *(const u32x4*)(Y + p1 * DM + c), b = *(const u32x4*)(Y + p2 * DM + c);
            float* op = KOUT + (size_t)row * DM + c; const u32x4 hw = *(const u32x4*)(hbp + (size_t)row * DM + c);
            f32x4 o0 = {bf_lo(hw.x), bf_hi(hw.x), bf_lo(hw.y), bf_hi(hw.y)}, o1 = {bf_lo(hw.z), bf_hi(hw.z), bf_lo(hw.w), bf_hi(hw.w)};
            o0[0] += g1 * bf_lo(a.x) + g2 * bf_lo(b.x); o0[1] += g1 * bf_hi(a.x) + g2 * bf_hi(b.x); o0[2] += g1 * bf_lo(a.y) + g2 * bf_lo(b.y); o0[3] += g1 * bf_hi(a.y) + g2 * bf_hi(b.y);
            o1[0] += g1 * bf_lo(a.z) + g2 * bf_lo(b.z); o1[1] += g1 * bf_hi(a.z) + g2 * bf_hi(b.z); o1[2] += g1 * bf_lo(a.w) + g2 * bf_lo(b.w); o1[3] += g1 * bf_hi(a.w) + g2 * bf_hi(b.w);
            *(f32x4*)op = o0; *(f32x4*)(op + 4) = o1; }
    }
}

__device__ __forceinline__ void phase_scores(Ctx& C) {
    const int tidl = tid_l(), lane = tidl & 63; (void)lane;
    unsigned char* const wsl = launder(C.ws); unsigned* const ctll = (unsigned*)(wsl + WS_CTL); (void)ctll;
    const bf16_t* iq = (const bf16_t*)(wsl + WS_PROJ + PJ_IQ); const bf16_t* ik = (const bf16_t*)(wsl + WS_PROJ + PJ_IK);
    const float* iw = (const float*)(wsl + WS_PROJ + PJ_IW); float* sc = (float*)(wsl + WS_BIG);
    const int r = lane & 31, hi = lane >> 5;
    for (int U = C.bx; U < NBATCH * 288; U += C.G) {
        int b, n, g;
        { const int rnd = U / C.G, cc = U - rnd * C.G; const int k = (C.G == 256) ? rnd * 256 + ((rnd & 1) ? 255 - cc : cc) : U;
          if (k < 928) { b = k & 3; const int kk = k >> 2; int j = 1; while (4 * (j + 1) * j <= kk) ++j; const int r_ = kk - 4 * j * (j - 1); n = 8 * j + r_ / j - 1; g = r_ % j; }
          else { const int idx = k - 928, sz = 7 - (idx >> 5), t = (idx >> 2) & 7; b = idx & 3; n = 8 * t + sz - 1; g = t; } }
        const int t0 = b * SEQ + 64 * n + 8 * C.wave;
        bf16x8 Af[4][4]; f32x4 wv[4][4];
#pragma unroll
        for (int blk = 0; blk < 4; ++blk) { const int qi = 2 * blk + ((r >> 2) & 1), head = 4 * (r >> 3) + (r & 3);
            const bf16_t* p = iq + (size_t)(t0 + qi) * 1024 + head * 64 + 8 * hi;
#pragma unroll
            for (int ks = 0; ks < 4; ++ks) Af[blk][ks] = *(const bf16x8*)(p + 16 * ks);
            const float* wp = iw + (size_t)(t0 + 2 * blk + hi) * 16;
#pragma unroll
            for (int i = 0; i < 4; ++i) wv[blk][i] = *(const f32x4*)(wp + 4 * i); }
        const int kt1 = (8 * g + 8 < n + 1) ? 8 * g + 8 : n + 1, ntile = kt1 - 8 * g;
        __syncthreads();
        { const unsigned char* src = (const unsigned char*)(ik + (size_t)(b * SEQ + 512 * g) * 64);
          for (int off = tidl * 16; off < ntile * 8192; off += 512 * 16) { const int row = off >> 7, ch = (off >> 4) & 7;
              *(LAS u32x4*)(C.lds + row * 128 + ((ch ^ ((row >> 1) & 7)) << 4)) = *(const u32x4*)(src + off); } }
        __syncthreads();
#define SC_TILE(kt) do { bf16x8 Bf[2][4]; \
            _Pragma("unroll") for (int kb = 0; kb < 2; ++kb) { const int row_ = 64 * ((kt) - 8 * g) + 32 * kb + r; \
                _Pragma("unroll") for (int ks = 0; ks < 4; ++ks) Bf[kb][ks] = *(const LAS bf16x8*)(C.lds + row_ * 128 + (((2 * ks + hi) ^ ((row_ >> 1) & 7)) << 4)); } \
            _Pragma("unroll") for (int blk = 0; blk < 4; ++blk) { f32x16 a0 = {}, a1 = {}; \
            _Pragma("unroll") for (int ks = 0; ks < 4; ++ks) { a0 = __builtin_amdgcn_mfma_f32_32x32x16_bf16(Af[blk][ks], Bf[0][ks], a0, 0, 0, 0); a1 = __builtin_amdgcn_mfma_f32_32x32x16_bf16(Af[blk][ks], Bf[1][ks], a1, 0, 0, 0); } \
            float s0 = 0.f, s1 = 0.f; \
            _Pragma("unroll") for (int i = 0; i < 16; ++i) { s0 += wv[blk][i >> 2][i & 3] * __builtin_amdgcn_fmed3f(a0[i], 0.f, 3.0e38f); s1 += wv[blk][i >> 2][i & 3] * __builtin_amdgcn_fmed3f(a1[i], 0.f, 3.0e38f); }     \
            float* o_ = sc + (size_t)(t0 + 2 * blk + hi) * SEQ + 64 * (kt) + r; o_[0] = s0; o_[32] = s1; } } while (0)
        for (int kt = 8 * g; kt < kt1; ++kt) SC_TILE(kt);
#undef SC_TILE
    }
}

__device__ __forceinline__ void phase_select(Ctx& C) {
    const int tidl = tid_l(), lane = tidl & 63;
    unsigned char* const wsl = launder(C.ws);
    const float* sc = (const float*)(wsl + WS_BIG); unsigned long long* mask = (unsigned long long*)(wsl + WS_MASK);
    LAS unsigned* hist = (LAS unsigned*)(C.lds + C.wave * 16384);
    for (int row = C.gw; row < NTOK; row += C.NGW) {
        const int n = (row & (SEQ - 1)) >> 6;
        unsigned wlo, whi;
        if (n < 4) { wlo = (lane <= n) ? 0xffffffffu : 0u; whi = wlo; }
        else {
            const bool act = lane <= n;
            float key[64];
            { const f32x4* sr = (const f32x4*)(sc + (size_t)row * SEQ + 64 * lane);
#pragma unroll
              for (int i = 0; i < 16; ++i) { f32x4 v = {0.f, 0.f, 0.f, 0.f}; if (act) v = sr[i]; key[4 * i] = v[0]; key[4 * i + 1] = v[1]; key[4 * i + 2] = v[2]; key[4 * i + 3] = v[3]; } }
            float mn = 3.0e38f, mx = -3.0e38f;
#pragma unroll
            for (int j = 0; j < 64; ++j) { mn = fminf(mn, key[j]); mx = fmaxf(mx, key[j]); }
            if (!act) { mn = 3.0e38f; mx = -3.0e38f; }
#pragma unroll
            for (int o = 1; o < 64; o <<= 1) { mn = fminf(mn, __shfl_xor(mn, o)); mx = fmaxf(mx, __shfl_xor(mx, o)); }
            const float rng = mx - mn, scale = rng > 0.f ? 4095.5f / rng : 0.f;
            { const u32x4 z = {0u, 0u, 0u, 0u};
#pragma unroll
              for (int i = 0; i < 16; ++i) *(LAS u32x4*)(hist + 4 * (lane + 64 * i)) = z; }
            LDS_WAIT();
            int bin[64];
#pragma unroll
            for (int j = 0; j < 64; ++j) { int bq = (int)((key[j] - mn) * scale); bq = bq > 4095 ? 4095 : bq; bin[j] = bq; }
            if (act) {
#pragma unroll
                for (int j = 0; j < 64; ++j) __hip_atomic_fetch_add(hist + bin[j], 1u, __ATOMIC_RELAXED, __HIP_MEMORY_SCOPE_WORKGROUP);
            }
            LDS_WAIT(); asm volatile("" ::: "memory");
            unsigned h[64]; unsigned cl = 0u;
#pragma unroll
            for (int i = 0; i < 16; ++i) { const u32x4 v = *(const LAS u32x4*)(hist + 64 * lane + 4 * i); h[4 * i] = v[0]; h[4 * i + 1] = v[1]; h[4 * i + 2] = v[2]; h[4 * i + 3] = v[3]; cl += (v[0] + v[1]) + (v[2] + v[3]); }
            unsigned suf = cl;
#pragma unroll
            for (int o = 1; o < 64; o <<= 1) { const unsigned t = __shfl_down(suf, o); if (lane + o < 64) suf += t; }
            const unsigned above = suf - cl;
            unsigned run = above; int bsel = -1; unsigned cab = 0u;
#pragma unroll
            for (int i = 63; i >= 0; --i) { const unsigned prev = run; run += h[i]; if (run >= 256u && prev < 256u) { bsel = i; cab = prev; } }
            const unsigned long long ff = __ballot(bsel >= 0);
            const int Ls = __builtin_ctzll(ff);
            const int B = __shfl(64 * lane + bsel, Ls); const int chi = (int)__shfl(cab, Ls);
            int need = 256 - chi;
            unsigned hlo = 0u, hhi = 0u, clo = 0u, chh = 0u;
#pragma unroll
            for (int j = 0; j < 32; ++j) { hlo |= (bin[j] > B) ? (1u << j) : 0u; clo |= (bin[j] == B) ? (1u << j) : 0u; hhi |= (bin[32 + j] > B) ? (1u << j) : 0u; chh |= (bin[32 + j] == B) ? (1u << j) : 0u; }
            if (!act) { hlo = 0u; hhi = 0u; clo = 0u; chh = 0u; }
            int m = __builtin_popcount(clo) + __builtin_popcount(chh);
#pragma unroll
            for (int o = 1; o < 64; o <<= 1) m += __shfl_xor(m, o);
            unsigned slo = clo, shi = chh;
            if (m != need) {
                slo = 0u; shi = 0u;
                for (int it = 0; it < need; ++it) {
                    float bk = -3.0e38f; int bj = 64;
#pragma unroll
                    for (int j = 0; j < 64; ++j) { const unsigned cb = j < 32 ? (clo & ~slo) : (chh & ~shi); const bool c = ((cb >> (j & 31)) & 1u) && (key[j] > bk); bk = c ? key[j] : bk; bj = c ? j : bj; }
                    float wm = bk;
#pragma unroll
                    for (int o = 1; o < 64; o <<= 1) wm = fmaxf(wm, __shfl_xor(wm, o));
                    const unsigned long long wf = __ballot(bj < 64 && bk == wm);
                    const int wl = __builtin_ctzll(wf);
                    if (lane == wl) { if (bj < 32) slo |= 1u << bj; else shi |= 1u << (bj - 32); }
                }
            }
            wlo = hlo | slo; whi = hhi | shi;
        }
        mask[(size_t)row * 64 + lane] = ((unsigned long long)whi << 32) | wlo;
    }
}

namespace at {
constexpr int D = 128, KVBLK = 64;
constexpr int SHM_V = KVBLK * D * 2, SHM_K = KVBLK * D * 2;
constexpr int NBUF = 3;
constexpr int OFF_WS = NBUF * SHM_V + NBUF * SHM_K, OFF_BIAS = OFF_WS + 8 * 64 * 4, LDS_BYTES = OFF_BIAS + 4 * 160 * 4;
constexpr float THR2 = 11.5f;
#define KSWZ(row, colB) ((row) * 256 + ((colB) ^ (((row) & 7) << 4)))
#define SBAR() __builtin_amdgcn_sched_barrier(0)
__device__ __forceinline__ int crow(int r, int hi) { return (r & 3) + 8 * (r >> 2) + 4 * hi; }
__device__ __forceinline__ void partialSM(f32x16& p0, f32x16& p1, float& m_reg, float& mn, float& alpha) {
    float pmax = p0[0];
#pragma unroll
    for (int r = 1; r < 16; ++r) pmax = fmaxf(pmax, p0[r]);
#pragma unroll
    for (int r = 0; r < 16; ++r) pmax = fmaxf(pmax, p1[r]);
    { auto rr = __builtin_amdgcn_permlane32_swap(__float_as_uint(pmax), __float_as_uint(pmax), false, false);
      pmax = fmaxf(__uint_as_float(rr[0]), __uint_as_float(rr[1])); }
    { const bool keep = __all(pmax - m_reg <= THR2);
      const float mcand = fmaxf(m_reg, pmax); mn = keep ? m_reg : mcand; alpha = keep ? 1.f : __builtin_amdgcn_exp2f(m_reg - mcand); m_reg = mn; }
#pragma unroll
    for (int r = 0; r < 16; ++r) p0[r] = p0[r] - mn;
#pragma unroll
    for (int r = 0; r < 16; ++r) p1[r] = p1[r] - mn;
#pragma unroll
    for (int r = 0; r < 16; ++r) p0[r] = __builtin_amdgcn_exp2f(p0[r]);
}
__device__ __forceinline__ void finishSM(f32x16& p0, f32x16& p1, float alpha, float& l_reg, bf16x8& pa0, bf16x8& pa1, bf16x8& pa2, bf16x8& pa3) {
#pragma unroll
    for (int r = 0; r < 16; ++r) p1[r] = __builtin_amdgcn_exp2f(p1[r]);
    float ps = 0;
#pragma unroll
    for (int r = 0; r < 16; ++r) ps += p0[r];
#pragma unroll
    for (int r = 0; r < 16; ++r) ps += p1[r];
    { auto rr = __builtin_amdgcn_permlane32_swap(__float_as_uint(ps), __float_as_uint(ps), false, false);
      ps = __uint_as_float(rr[0]) + __uint_as_float(rr[1]); }
    l_reg = l_reg * alpha + ps;
#define PK4(P, BASE, OUT) do { unsigned a0 = cvt_pk_bf16(P[BASE + 0], P[BASE + 1]), a1 = cvt_pk_bf16(P[BASE + 2], P[BASE + 3]);   \
    unsigned b0 = cvt_pk_bf16(P[BASE + 4], P[BASE + 5]), b1 = cvt_pk_bf16(P[BASE + 6], P[BASE + 7]);                              \
    auto r0 = __builtin_amdgcn_permlane32_swap(a0, b0, false, false); auto r1 = __builtin_amdgcn_permlane32_swap(a1, b1, false, false); \
    u32x4 w = {r0[0], r1[0], r0[1], r1[1]}; OUT = *reinterpret_cast<bf16x8*>(&w); } while (0)
    PK4(p0, 0, pa0); PK4(p0, 8, pa1); PK4(p1, 0, pa2); PK4(p1, 8, pa3);
#undef PK4
}
__device__ __forceinline__ void qkt(f32x16& p0, f32x16& p1, const LAS char* Ks, const bf16x8* qr, int r32, int hi) {
    p0 = f32x16{}; p1 = f32x16{};
#pragma unroll
    for (int d0 = 0; d0 < 8; ++d0) { const int cb = (d0 * 16 + hi * 8) * 2;
        const bf16x8 b0 = *(const LAS bf16x8*)(Ks + KSWZ(r32, cb));
        const bf16x8 b1 = *(const LAS bf16x8*)(Ks + KSWZ(32 + r32, cb));
        p0 = __builtin_amdgcn_mfma_f32_32x32x16_bf16(b0, qr[d0], p0, 0, 0, 0);
        p1 = __builtin_amdgcn_mfma_f32_32x32x16_bf16(b1, qr[d0], p1, 0, 0, 0); }
}
__device__ __forceinline__ int v_st(int k, int c) { const int kk = (k & ~0xC) | ((k & 4) << 1) | ((k & 8) >> 1); return ((kk >> 3) * 4 + (c >> 5)) * 512 + ((kk & 7) * 32 + (c & 31)) * 2; }
__device__ __forceinline__ int v_rd_base(int lane) { return ((lane & 3) << 3) | (((lane >> 2) & 3) << 6) | (((lane >> 4) & 1) << 5) | (((lane >> 5) & 1) << 8); }
constexpr int v_rd_off(int d0, int ks, int half) { return d0 * 512 + ks * 4096 + half * 2048; }
template <int OFF> __device__ __forceinline__ s16x4 tr_read(const LAS char* vb) { return __builtin_amdgcn_ds_read_tr16_b64_v4i16((LAS s16x4*)(vb + OFF)); }
template <int KS> __device__ __forceinline__ void pv_step(f32x16* o, const LAS char* vb, bf16x8 pa) {
#define PK(L, H) (bf16x8){L[0], L[1], L[2], L[3], H[0], H[1], H[2], H[3]}
    { const s16x4 l = tr_read<v_rd_off(0, KS, 0)>(vb), h = tr_read<v_rd_off(0, KS, 1)>(vb); o[0] = __builtin_amdgcn_mfma_f32_32x32x16_bf16(pa, PK(l, h), o[0], 0, 0, 0); }
    { const s16x4 l = tr_read<v_rd_off(1, KS, 0)>(vb), h = tr_read<v_rd_off(1, KS, 1)>(vb); o[1] = __builtin_amdgcn_mfma_f32_32x32x16_bf16(pa, PK(l, h), o[1], 0, 0, 0); }
    { const s16x4 l = tr_read<v_rd_off(2, KS, 0)>(vb), h = tr_read<v_rd_off(2, KS, 1)>(vb); o[2] = __builtin_amdgcn_mfma_f32_32x32x16_bf16(pa, PK(l, h), o[2], 0, 0, 0); }
    { const s16x4 l = tr_read<v_rd_off(3, KS, 0)>(vb), h = tr_read<v_rd_off(3, KS, 1)>(vb); o[3] = __builtin_amdgcn_mfma_f32_32x32x16_bf16(pa, PK(l, h), o[3], 0, 0, 0); }
#undef PK
}
__device__ __forceinline__ void pv_d0(f32x16* o, const LAS char* vb, bf16x8 pa0, bf16x8 pa1, bf16x8 pa2, bf16x8 pa3) {
    pv_step<0>(o, vb, pa0); pv_step<1>(o, vb, pa1); pv_step<2>(o, vb, pa2); pv_step<3>(o, vb, pa3);
}
__device__ __forceinline__ void bias_tile(f32x16& p0, f32x16& p1, int hi, const LAS float* bt, int relbase) {
#pragma unroll
    for (int r = 0; r < 16; ++r) { const int kc = (r & 3) + 8 * (r >> 2); int i0 = relbase + kc + 4 * hi; i0 = i0 < 0 ? 0 : i0; int i1 = relbase + 32 + kc + 4 * hi; i1 = i1 < 0 ? 0 : i1;
        p0[r] += bt[i0]; p1[r] += bt[i1]; }
}
__device__ __forceinline__ void mask_tile(f32x16& p0, f32x16& p1, unsigned long long mw, int hi) {
    const float ninf = -__builtin_inff();
    const unsigned lo = (unsigned)mw >> (4 * hi), hw = (unsigned)(mw >> 32) >> (4 * hi);
#pragma unroll
    for (int r = 0; r < 16; ++r) { const unsigned bit = 1u << ((r & 3) + 8 * (r >> 2)); p0[r] = (lo & bit) ? p0[r] : ninf; p1[r] = (hw & bit) ? p1[r] : ninf; }
}
__device__ __forceinline__ void qkt_m(f32x16& p0, f32x16& p1, const LAS char* Ks, const bf16x8* qr, int r32, int hi, unsigned long long mw) {
    const int nlo = (int)~((unsigned)mw >> (4 * hi)), nhw = (int)~((unsigned)(mw >> 32) >> (4 * hi));
#pragma unroll
    for (int r = 0; r < 16; ++r) { const unsigned pos = (r & 3) + 8 * (r >> 2);
        p0[r] = __uint_as_float((unsigned)__builtin_amdgcn_sbfe(nlo, pos, 1u) & 0xff800000u); p1[r] = __uint_as_float((unsigned)__builtin_amdgcn_sbfe(nhw, pos, 1u) & 0xff800000u); }
#pragma unroll
    for (int d0 = 0; d0 < 8; ++d0) { const int cb = (d0 * 16 + hi * 8) * 2;
        const bf16x8 b0 = *(const LAS bf16x8*)(Ks + KSWZ(r32, cb));
        const bf16x8 b1 = *(const LAS bf16x8*)(Ks + KSWZ(32 + r32, cb));
        p0 = __builtin_amdgcn_mfma_f32_32x32x16_bf16(b0, qr[d0], p0, 0, 0, 0);
        p1 = __builtin_amdgcn_mfma_f32_32x32x16_bf16(b1, qr[d0], p1, 0, 0, 0); }
}
__device__ __forceinline__ int t5_bucket(int rel) {
    const int n = rel < 0 ? -rel : rel; int bk;
    if (n < 8) bk = n; else if (n < 12) bk = 8; else if (n < 16) bk = 9; else if (n < 23) bk = 10; else if (n < 32) bk = 11; else if (n < 46) bk = 12; else if (n < 64) bk = 13; else if (n < 91) bk = 14; else bk = 15;
    return bk + (rel > 0 ? 16 : 0);
}

template <int PVAR> __device__ __forceinline__ void attn_unit(const bf16_t* __restrict__ Q, const bf16_t* __restrict__ K, const bf16_t* __restrict__ V, const unsigned long long* __restrict__ mask,
                                          const float* __restrict__ rel_bias, unsigned char* __restrict__ mix, int b, int kvh, int n, LAS char* lds) {
#define PV_ON(bit) (!(PVAR & (bit)))
    const int tid = tid_l(), wid = tid >> 6, lane = tid & 63, r32 = lane & 31, hi = lane >> 5;
    const int hl = wid >> 1, qsub = wid & 1, hq = kvh * 4 + hl, tq = 64 * n + 32 * qsub + r32;
    LAS char* V_lds = lds; LAS char* K_lds = lds + NBUF * SHM_V;
    LAS float* wsw = (LAS float*)(lds + OFF_WS) + wid * 64; LAS float* li_l = wsw; LAS float* al_l = wsw + 32;
    LAS float* btab = (LAS float*)(lds + OFF_BIAS);
    for (int i = tid; i < 4 * 160; i += 512) { const int h4 = i / 160, idx = i % 160; const int rel = idx - 91; float v = 0.f;
        if (idx < 155) v = (rel_bias[t5_bucket(rel) * AH + kvh * 4 + h4] - rel_bias[15 * AH + kvh * 4 + h4]) * LOG2E;
        btab[i] = v; }
    float m_reg = -1e30f, l_reg = 0; f32x16 o[4] = {}; bf16x8 qr[8];
    const bf16_t* Qw = Q + (size_t)(b * SEQ + tq) * 1024 + hq * 128 + hi * 8;
#pragma unroll
    for (int d0 = 0; d0 < 8; ++d0) qr[d0] = *(const bf16x8*)(Qw + d0 * 16);
    const bf16_t* Kh = K + (size_t)b * SEQ * 256 + kvh * 128; const bf16_t* Vh = V + (size_t)b * SEQ * 256 + kvh * 128;
    const unsigned long long* mrow = mask + (size_t)(b * SEQ + tq) * 64;
    const LAS float* bt = btab + hl * 160;
    const int sr = tid >> 4, sc = (tid & 15) * 8, vst0 = v_st(sr, sc), vst1 = v_st(32 + sr, sc);
    const LAS char* vb0 = V_lds + v_rd_base(lane);
    bf16x8 sv0, sv1, sk0, sk1;
#define SLOAD(k0) do { sv0 = *(const bf16x8*)(&Vh[(size_t)((k0) + sr) * 256 + sc]); sv1 = *(const bf16x8*)(&Vh[(size_t)((k0) + 32 + sr) * 256 + sc]); \
    sk0 = *(const bf16x8*)(&Kh[(size_t)((k0) + sr) * 256 + sc]); sk1 = *(const bf16x8*)(&Kh[(size_t)((k0) + 32 + sr) * 256 + sc]); } while (0)
#define SWRITE(bb) do { *(LAS bf16x8*)(V_lds + (bb) * SHM_V + vst0) = sv0; *(LAS bf16x8*)(V_lds + (bb) * SHM_V + vst1) = sv1; const int kc = sc * 2; \
    *(LAS bf16x8*)(K_lds + (bb) * SHM_K + KSWZ(sr, kc)) = sk0; *(LAS bf16x8*)(K_lds + (bb) * SHM_K + KSWZ(32 + sr, kc)) = sk1; } while (0)
#define RESC(a) do { if (__any((a) < 1.f)) { if (hi == 0) al_l[r32] = (a); asm volatile("s_waitcnt lgkmcnt(0)" ::: "memory"); \
    _Pragma("unroll") for (int d = 0; d < 4; ++d) _Pragma("unroll") for (int r = 0; r < 16; ++r) o[d][r] *= al_l[crow(r, hi)]; } } while (0)
    f32x16 pA0, pA1, pB0, pB1; float mnA, mnB, alA, alB; bf16x8 pa0, pa1, pa2, pa3;
    const int NT = (n + 2) & ~1;
#define BIAST(P0, P1, kt) do { if ((kt) + 2 >= n && (kt) <= n) bias_tile(P0, P1, hi, bt, 64 * ((kt) - n) - 32 * qsub - r32 + 91); } while (0)
#define SG_R1() do { _Pragma("unroll") for (int g_ = 0; g_ < 16; ++g_) { __builtin_amdgcn_sched_group_barrier(0x008, 1, 0); __builtin_amdgcn_sched_group_barrier(0x100, 1, 0); __builtin_amdgcn_sched_group_barrier(0x002, 5, 0); } } while (0)
#define SG_R2() do { _Pragma("unroll") for (int g_ = 0; g_ < 16; ++g_) { __builtin_amdgcn_sched_group_barrier(0x008, 1, 0); __builtin_amdgcn_sched_group_barrier(0x100, 2, 0); __builtin_amdgcn_sched_group_barrier(0x002, 12, 0); } } while (0)
    unsigned long long mwA = mrow[0], mwB = mrow[1];
    SLOAD(0); asm volatile("s_waitcnt vmcnt(0)" ::: "memory"); SWRITE(0); SLOAD(KVBLK); __syncthreads();
    qkt(pA0, pA1, K_lds, qr, r32, hi); BIAST(pA0, pA1, 0); mask_tile(pA0, pA1, mwA, hi); partialSM(pA0, pA1, m_reg, mnA, alA);
    SWRITE(1); if (2 < NT) SLOAD(2 * KVBLK); __syncthreads();
    int b0 = 0, b1 = 1, b2 = 2;
    for (int j = 1; j + 1 < NT; j += 2) {
        if constexpr ((PVAR & 7) == 0) {
        SBAR(); qkt_m(pB0, pB1, K_lds + b1 * SHM_K, qr, r32, hi, mwB);
        finishSM(pA0, pA1, alA, l_reg, pa0, pa1, pa2, pa3); SG_R1(); SBAR();
        BIAST(pB0, pB1, j);
        SBAR(); pv_d0(o, vb0 + b0 * SHM_V, pa0, pa1, pa2, pa3); partialSM(pB0, pB1, m_reg, mnB, alB); SG_R2(); SBAR();
        RESC(alB);
        SWRITE(b2); mwA = mrow[j + 1]; SLOAD((j + 2) * KVBLK);
        __syncthreads();
        SBAR(); qkt_m(pA0, pA1, K_lds + b2 * SHM_K, qr, r32, hi, mwA);
        finishSM(pB0, pB1, alB, l_reg, pa0, pa1, pa2, pa3); SG_R1(); SBAR();
        BIAST(pA0, pA1, j + 1);
        SBAR(); pv_d0(o, vb0 + b1 * SHM_V, pa0, pa1, pa2, pa3); partialSM(pA0, pA1, m_reg, mnA, alA); SG_R2(); SBAR();
        RESC(alA);
        SWRITE(b0); mwB = mrow[j + 2]; if (j + 3 < NT) SLOAD((j + 3) * KVBLK);
        __syncthreads();
        { const int t0_ = b0; b0 = b2; b2 = b1; b1 = t0_; }
        } else {
        if constexpr (PV_ON(2)) qkt(pB0, pB1, K_lds + b1 * SHM_K, qr, r32, hi);
        if constexpr (PV_ON(1)) { finishSM(pA0, pA1, alA, l_reg, pa0, pa1, pa2, pa3); BIAST(pB0, pB1, j); }
        if constexpr (PV_ON(2)) pv_d0(o, vb0 + b0 * SHM_V, pa0, pa1, pa2, pa3);
        if constexpr (PV_ON(1)) { mask_tile(pB0, pB1, mwB, hi); partialSM(pB0, pB1, m_reg, mnB, alB); RESC(alB); }
        if constexpr (PV_ON(4)) { SWRITE(b2); mwA = mrow[j + 1]; SLOAD((j + 2) * KVBLK); }
        __syncthreads();
        if constexpr (PV_ON(2)) qkt(pA0, pA1, K_lds + b2 * SHM_K, qr, r32, hi);
        if constexpr (PV_ON(1)) { finishSM(pB0, pB1, alB, l_reg, pa0, pa1, pa2, pa3); BIAST(pA0, pA1, j + 1); }
        if constexpr (PV_ON(2)) pv_d0(o, vb0 + b1 * SHM_V, pa0, pa1, pa2, pa3);
        if constexpr (PV_ON(1)) { mask_tile(pA0, pA1, mwA, hi); partialSM(pA0, pA1, m_reg, mnA, alA); RESC(alA); }
        if constexpr (PV_ON(4)) { SWRITE(b0); mwB = mrow[j + 2]; if (j + 3 < NT) SLOAD((j + 3) * KVBLK); }
        __syncthreads();
        { const int t0_ = b0; b0 = b2; b2 = b1; b1 = t0_; }
        }
    }
    SBAR(); qkt_m(pB0, pB1, K_lds + b1 * SHM_K, qr, r32, hi, mwB);
    finishSM(pA0, pA1, alA, l_reg, pa0, pa1, pa2, pa3); SG_R1(); SBAR();
    BIAST(pB0, pB1, NT - 1);
    SBAR(); pv_d0(o, vb0 + b0 * SHM_V, pa0, pa1, pa2, pa3); partialSM(pB0, pB1, m_reg, mnB, alB); SG_R2(); SBAR();
    RESC(alB);
    finishSM(pB0, pB1, alB, l_reg, pa0, pa1, pa2, pa3); SBAR();
    pv_d0(o, vb0 + b1 * SHM_V, pa0, pa1, pa2, pa3);
#undef BIAST
#undef SG_R1
#undef SG_R2
    if (hi == 0) li_l[r32] = l_reg; asm volatile("s_waitcnt lgkmcnt(0)" ::: "memory");
    float rli[16];
#pragma unroll
    for (int r = 0; r < 16; ++r) rli[r] = __builtin_amdgcn_rcpf(li_l[crow(r, hi)]);
    unsigned char* Ow = mix + (size_t)(b * SEQ + 64 * n + 32 * qsub) * DM + hq * 128;
#pragma unroll
    for (int r = 0; r < 16; ++r) { const int orow = crow(r, hi);
#pragma unroll
        for (int d0 = 0; d0 < 4; ++d0) Ow[(size_t)orow * DM + d0 * 32 + r32] = (unsigned char)(cvt_pk4_fp8(o[d0][r] * (rli[r] * S_MIX8), 0.f, 0.f, 0.f) & 0xffu); }
    __syncthreads();
#undef SLOAD
#undef SWRITE
#undef RESC
}
}

template <int PVAR> __device__ __forceinline__ void phase_attn(Ctx& C) {
    const int tidl = tid_l(), lane = tidl & 63; (void)lane;
    unsigned char* const wsl = launder(C.ws); unsigned* const ctll = (unsigned*)(wsl + WS_CTL); (void)ctll;
    const bf16_t* Q = (const bf16_t*)(wsl + WS_PROJ + PJ_Q); const bf16_t* K = (const bf16_t*)(wsl + WS_PROJ + PJ_K); const bf16_t* V = (const bf16_t*)(wsl + WS_PROJ + PJ_V);
    const unsigned long long* mask = (const unsigned long long*)(wsl + WS_MASK); unsigned char* mix = (unsigned char*)(wsl + WS_MIX);
    for (int p = C.bx; p < 256; p += C.G) { const int j = p >> 3, bk = p & 7;
        at::attn_unit<PVAR>(Q, K, V, mask, KIN(1), mix, bk >> 1, bk & 1, 63 - j, (LAS char*)C.lds);
        at::attn_unit<PVAR>(Q, K, V, mask, KIN(1), mix, bk >> 1, bk & 1, j, (LAS char*)C.lds); }
}

constexpr int NWAVES = 8;
constexpr int RING_BYTES = 131072, MISC_OFF = 143360, LDS_BYTES = 147456;
constexpr int PH_PER_LAYER = 10, NPH = 1 + NLAYER * PH_PER_LAYER;
#ifndef STG_INPROJ
#define STG_INPROJ 250u
#endif
#ifndef MK_PER_PHASE
#define MK_PER_PHASE 0
#endif


__device__ __forceinline__ Ctx make_ctx() {
    extern __shared__ __attribute__((aligned(16))) unsigned char lds_raw[];
    Ctx C; C.lds = (LAS unsigned char*)lds_raw; KArgs ka = kargs(); C.ws = as_global((unsigned char*)ka->ws); C.ctl = (unsigned*)(C.ws + WS_CTL);
    C.wave = __builtin_amdgcn_readfirstlane(tid_l() >> 6); int bx = (int)blockIdx.x; asm volatile("" : "+s"(bx)); C.bx = bx; C.G = gridDim.x; C.gw = bx * NWAVES + C.wave; C.NGW = C.G * NWAVES; return C;
}
__device__ __forceinline__ void seam() {
    extern __shared__ __attribute__((aligned(16))) unsigned char lds_raw[];
    XcdBarrier b; b.bar = as_global((unsigned*)((unsigned char*)kargs()->ws + WS_CTL) + CW_BAR); b.x = xb_xcc_id(); b.st = (volatile LAS unsigned*)((LAS unsigned char*)lds_raw + MISC_OFF) + 8;
    xcd_barrier(b);
}
#ifndef ONLY
#define ONLY -1
#endif
#define SITE(s) (ONLY < 0 || ONLY == (s))
#define IN(k) (kargs()->ph_lo <= (k) && (k) < kargs()->ph_hi)
#define SEAM(k) do { if (IN((k) + 1)) seam(); } while (0)
#ifndef PROBE_DUP
#define PROBE_DUP -1
#endif
#ifndef PROBE_DUP2
#define PROBE_DUP2 -1
#endif
#ifndef PROBE_DUP3
#define PROBE_DUP3 -1
#endif
#ifndef PROBE_DUP4
#define PROBE_DUP4 -1
#endif
#define DUPX(s)
#define DUP_UNUSED(s) for (int rep_ = 0; rep_ < ((PROBE_DUP == (s) || PROBE_DUP2 == (s) || PROBE_DUP3 == (s) || PROBE_DUP4 == (s)) ? 2 : 1); ++rep_)
#define CTX() Ctx C = make_ctx(); LAS unsigned char* const ring = C.lds; (void)ring
#define LSITE 0
template <int l, int PVAR> __device__ __forceinline__ void layer_program() {
    constexpr int pb = 1 + l * PH_PER_LAYER;
#define SUB_BEGIN { CTX(); unsigned char* const wsl = launder(C.ws); unsigned char* const pj = wsl + WS_PROJ; const float* const rstd = (const float*)(wsl + WS_SMALL + SM_RSTD); (void)pj; (void)rstd; (void)ring;
#define SUB_END }
#define SITE_BEGIN(sid, k) if (SITE(sid) && IN(pb + (k))) { SUB_BEGIN
#define SITE_END(k) SUB_END SEAM(pb + (k)); }
    if constexpr (l != 0) { SITE_BEGIN(0, 0) phase_rstd(C); SITE_END(0) }
    SITE_BEGIN(1, 1)
        SchedDense S{(const char*)(wsl + WS_HB8), (const char*)(wsl + WS_W_IN) + (size_t)l * INP * DM, DM, DM, NTOK / 256, INP / 256, DM / 128, C.G, C.bx};
        EpiInProj<true> E{pj, rstd, (const float*)(wsl + WS_ROPE), (const float*)(wsl + WS_ROPE) + SEQ * 128, (const float*)(wsl + WS_SMALL + SM_SA), (const float*)(wsl + WS_SMALL + SM_SBIN) + l * (INP / 256)};
        gm::gemm_phase<EpiInProj<true>, SchedDense, false, 2, (PVAR >> 8) & 15>(ring, S, E, DM, DM);
    SITE_END(1)
    SITE_BEGIN(2, 2)
          SchedRetTile S{(const char*)(pj + PJ_QP), (const char*)(pj + PJ_RK), 256 * 512 * 2, 0, 4, C.G, C.bx, 256 * 1024 * 2};
          EpiRetP E{(bf16_t*)(pj + PJ_QP)};
          if constexpr (!(PVAR & 0x4000)) gm::gemm_phase<EpiRetP, SchedRetTile, false>(ring, S, E, 512 * 2, 1024 * 2); SUB_END
        SUB_BEGIN SchedRetTile S{(const char*)(pj + PJ_SV) + 512, (const char*)(pj + PJ_KT), 256 * 512 * 2, 256 * 256 * 2, 4, C.G, C.bx, 0};
          EpiRetKV E{(float*)(pj + PJ_KVT)};
          if constexpr (!(PVAR & 0x4000)) gm::gemm_phase<EpiRetKV, SchedRetTile, false>(ring, S, E, 512 * 2, 256 * 2); SUB_END
        SUB_BEGIN if constexpr (!(PVAR & 0x2000)) phase_post(C, l); SUB_END
        SUB_BEGIN if constexpr (!(PVAR & 0x1000)) phase_scores(C);
    SITE_END(2)
    SITE_BEGIN(3, 3) if constexpr (!(PVAR & 0x8000)) phase_select(C); SUB_END SUB_BEGIN if constexpr (!(PVAR & 0x10000)) phase_retscan(C); SITE_END(3)
    SITE_BEGIN(4, 4) phase_attn<PVAR>(C); SUB_END
        SUB_BEGIN SchedRetTile S{(const char*)(pj + PJ_QP), (const char*)(pj + PJ_SV), 256 * 512 * 2, 256 * 512 * 2, 8, C.G, C.bx, 0};
          EpiRetOut E{(unsigned char*)(wsl + WS_MIX), (const bf16_t*)(pj + PJ_RG), KIN(6) + l * 1024, C.lds + RING_BYTES};
          if constexpr (!(PVAR & 8)) gm::gemm_phase<EpiRetOut, SchedRetTile, false>(ring, S, E, 512 * 2, 512 * 2);
    SITE_END(4)
    SITE_BEGIN(5, 5)
        SchedDense S{(const char*)(wsl + WS_MIX), (const char*)(wsl + WS_W_OUT) + (size_t)l * DM * DM, DM, DM, NTOK / 256, DM / 256, DM / 128, C.G, C.bx};
        EpiResid<l == 0> E{KIN(0), (bf16_t*)(wsl + WS_HB), 1.0f / (S_MIX8 * S_WOUT8)};
        gm::gemm_phase<EpiResid<l == 0>, SchedDense, false, 1>(ring, S, E, DM, DM);
    SITE_END(5)
    if constexpr (l == 0) {
        SITE_BEGIN(6, 6) phase_rstd(C); SITE_END(6)
        SITE_BEGIN(7, 7)
            SchedDense S{(const char*)(wsl + WS_HB8), (const char*)(wsl + WS_W_FUP), DM, DM, NTOK / 256, 2 * DFF / 256, DM / 128, C.G, C.bx};
            EpiFfnUp<true> E{(unsigned char*)(wsl + WS_BIG), rstd, (const float*)(wsl + WS_SMALL + SM_SA), (const float*)(wsl + WS_SMALL + SM_SBF)};
            gm::gemm_phase<EpiFfnUp<true>, SchedDense, false, 2>(ring, S, E, DM, DM);
        SITE_END(7)
        SITE_BEGIN(8, 8)
            SchedDense S{(const char*)(wsl + WS_BIG), (const char*)(wsl + WS_W_FDN), DFF, DFF, NTOK / 256, DM / 256, DFF / 128, C.G, C.bx};
            EpiResid<false> E{nullptr, (bf16_t*)(wsl + WS_HB), 1.0f / (S_H8 * S_WDN8)};
            gm::gemm_phase<EpiResid<false>, SchedDense, false, 1>(ring, S, E, DFF, DFF);
        SITE_END(8)
    } else {
        SITE_BEGIN(26, 6) phase_stats<true>(C, nullptr, l); SITE_END(6)
        SITE_BEGIN(27, 7)
            SchedMoeUp S{moe_info((unsigned*)(wsl + WS_CTL)), (const char*)(wsl + WS_HB8), (const char*)(wsl + WS_W_MUP), (const int*)(wsl + WS_SMALL + SM_LIST), C.G, C.bx};
            EpiMoeUp E{(unsigned char*)(wsl + WS_BIG), (const float*)(wsl + WS_SMALL + SM_RFAC), (const int*)(wsl + WS_SMALL + SM_LIST)};
            gm::gemm_phase<EpiMoeUp, SchedMoeUp, true, 1, (PVAR >> 4) & 7>(ring, S, E, DM, DM);
        SITE_END(7)
        SITE_BEGIN(28, 8)
            SchedMoeDown S{moe_info((unsigned*)(wsl + WS_CTL)), (const char*)(wsl + WS_BIG), (const char*)(wsl + WS_W_MDN), C.G, C.bx};
            EpiMoeDown E{(bf16_t*)(pj + PJ_Y)};
            gm::gemm_phase<EpiMoeDown, SchedMoeDown, false, 1>(ring, S, E, DFE, DFE);
        SITE_END(8)
        SITE_BEGIN(29, 9) phase_combine(C); SITE_END(9)
    }
#undef SITE_BEGIN
#undef SITE_END
#undef SUB_BEGIN
#undef SUB_END
}
template <int PVAR> __global__ void __launch_bounds__(NWAVES * 64, 2) mk_fwd_t(Args args) {
    extern __shared__ __attribute__((aligned(16))) unsigned char lds_raw[];
    {
        volatile LAS unsigned* MISC = (volatile LAS unsigned*)((LAS unsigned char*)lds_raw + MISC_OFF);
        if ((int)threadIdx.x < 32) MISC[(int)threadIdx.x] = 0u;
        __syncthreads();
        if (args.use_bar) (void)xcd_barrier_post((unsigned*)(args.ws + WS_CTL) + CW_BAR, MISC + 8);
    }

    if (SITE(100) && IN(0)) { { CTX(); phase_prepA(C); } { CTX(); phase_stats<false>(C, KIN(0), 0); } SEAM(0); }

    layer_program<0, PVAR>();
    layer_program<1, PVAR>();
#undef IN
#undef SEAM
}

extern "C" void kernel_launch(void* const* d_in, const int* in_sizes, int n_in, void* d_out, int out_size, void* d_ws, size_t ws_size, hipStream_t stream) {
    static int grid = 0;
    if (grid == 0) {
        if (n_in != 16 || out_size != NTOK * DM || ws_size < WS_END) { fprintf(stderr, "kernel_launch: unexpected shapes (n_in %d out %d ws %zu, need %zu)\n", n_in, out_size, ws_size, (size_t)WS_END); grid = -1; return; }
        int dev = 0, cus = 0, per_cu = 0;
        if (hipGetDevice(&dev) != hipSuccess || hipDeviceGetAttribute(&cus, hipDeviceAttributeMultiprocessorCount, dev) != hipSuccess) { grid = -1; return; }
        if (hipFuncSetAttribute((const void*)mk_fwd_t<0>, hipFuncAttributeMaxDynamicSharedMemorySize, LDS_BYTES) != hipSuccess) { fprintf(stderr, "kernel_launch: hipFuncSetAttribute failed\n"); grid = -1; return; }
        if (hipOccupancyMaxActiveBlocksPerMultiprocessor(&per_cu, (const void*)mk_fwd_t<0>, NWAVES * 64, LDS_BYTES) != hipSuccess || per_cu < 1) { fprintf(stderr, "kernel_launch: occupancy query says %d\n", per_cu); }
        (void)hipGetLastError();
        grid = cus;
    }
    if (grid < 0) return;
    if (hipMemsetAsync((char*)d_ws + WS_CTL, 0, CTL_ZERO_BYTES, stream) != hipSuccess) return;
    Args a{};
    for (int i = 0; i < 16; ++i) a.in[i] = (const float*)d_in[i];
    a.out = (float*)d_out; a.ws = (unsigned char*)d_ws; a.pad = 0;
#if MK_PER_PHASE
    for (int ph = 0; ph < NPH; ++ph) {
        if (ph == 1 + 9 || ph == 1) continue;
        a.ph_lo = ph; a.ph_hi = ph + 1; a.use_bar = 0;
#ifdef PROBE_PH
#ifndef PROBE_VAR
#define PROBE_VAR 0
#endif
        { const int pr[] = {PROBE_PH}; for (int q = 0; q < (int)(sizeof(pr) / sizeof(int)); ++q) if (pr[q] == ph) { hipFuncSetAttribute((const void*)mk_fwd_t<PROBE_VAR>, hipFuncAttributeMaxDynamicSharedMemorySize, LDS_BYTES); hipLaunchKernelGGL(mk_fwd_t<PROBE_VAR>, dim3(grid), dim3(NWAVES * 64), LDS_BYTES, stream, a); } }
#endif
        hipLaunchKernelGGL(mk_fwd_t<0>, dim3(grid), dim3(NWAVES * 64), LDS_BYTES, stream, a);

    }
#else
    a.ph_lo = 0; a.ph_hi = NPH; a.use_bar = 1;
    hipLaunchKernelGGL(mk_fwd_t<0>, dim3(grid), dim3(NWAVES * 64), LDS_BYTES, stream, a);
#endif
    const hipError_t le = hipPeekAtLastError();
    if (le != hipSuccess) fprintf(stderr, "kernel_launch: launch failed: %s\n", hipGetErrorName(le));
}
```
